# Optimizing an MI355X kernel written in HIP

```python
import jax, jax.numpy as jnp
from jax import lax
import numpy as np

D_MODEL = 2048
BATCH = 4
SEQ = 2048
DEPTH = 1
DEC_BATCH = 128
DEC_SEQ = 8
PAST_LEN = 16384
PAGE_SIZE = 128

HEAD_DIM = 64
ATTN_WIDTH = D_MODEL // 2
N_Q_HEADS = ATTN_WIDTH // HEAD_DIM
N_KV_HEADS = N_Q_HEADS // 4
Q_PER_KV = N_Q_HEADS // N_KV_HEADS
KV_WIDTH = N_KV_HEADS * HEAD_DIM
WINDOW = 128
BLOCK = WINDOW
SG_WIDTH = D_MODEL - ATTN_WIDTH
N_SG_HEADS = 8
SG_HEAD_DIM = SG_WIDTH // N_SG_HEADS
CHUNK = 128
D_FF = ((8 * D_MODEL // 3 + 255) // 256) * 256
IN_WIDTH = ATTN_WIDTH + 2 * KV_WIDTH + 2 * SG_WIDTH
ROPE_THETA = 10000.0
EPS = 1e-6

kernel_name = "hymba_swa_sink_gmlp_decode_step"


def rmsnorm(x, g):
    xf = x.astype(jnp.float32)
    r = lax.rsqrt(jnp.mean(xf * xf, axis=-1, keepdims=True) + EPS)
    return (xf * r * g.astype(jnp.float32)).astype(x.dtype)


def rope(x, pos):
    half = HEAD_DIM // 2
    inv = ROPE_THETA ** (-jnp.arange(half, dtype=jnp.float32) / half)
    ang = pos.astype(jnp.float32)[:, None] * inv[None, :]
    cos = jnp.cos(ang)[:, None, :]
    sin = jnp.sin(ang)[:, None, :]
    x1 = x[..., :half].astype(jnp.float32)
    x2 = x[..., half:].astype(jnp.float32)
    out = jnp.concatenate([x1 * cos - x2 * sin, x2 * cos + x1 * sin], axis=-1)
    return out.astype(x.dtype)


def project(xn, pos, w_in, q_norm, k_norm, sg_norm):
    b, s, _ = xn.shape
    proj = jnp.einsum('bsd,de->bse', xn, w_in)
    cuts = [ATTN_WIDTH, ATTN_WIDTH + KV_WIDTH, ATTN_WIDTH + 2 * KV_WIDTH,
            ATTN_WIDTH + 2 * KV_WIDTH + SG_WIDTH]
    q, k, v, u, g = jnp.split(proj, cuts, axis=-1)
    q = rope(rmsnorm(q.reshape(b, s, N_Q_HEADS, HEAD_DIM), q_norm), pos)
    k = rope(rmsnorm(k.reshape(b, s, N_KV_HEADS, HEAD_DIM), k_norm), pos)
    v = v.reshape(b, s, N_KV_HEADS, HEAD_DIM)
    u = jax.nn.gelu(u)
    g = rmsnorm(jax.nn.gelu(g), sg_norm)
    return q, k, v, u, g


def sink_attention(q, k, v, mask, sinks):
    scale = HEAD_DIM ** -0.5
    s = jnp.einsum('...qhgd,...khd->...hgqk', q.astype(jnp.float32), k.astype(jnp.float32)) * scale
    s = jnp.where(mask, s, -jnp.inf)
    sink = sinks.astype(jnp.float32).reshape(N_KV_HEADS, Q_PER_KV, 1, 1)
    m = jnp.maximum(jnp.max(s, axis=-1, keepdims=True), sink)
    p = jnp.exp(s - m)
    denom = jnp.sum(p, axis=-1, keepdims=True) + jnp.exp(sink - m)
    o = jnp.einsum('...hgqk,...khd->...qhgd', p / denom, v.astype(jnp.float32))
    return o.astype(v.dtype)


def attention_prompt(q, k, v, sinks):
    b, s = q.shape[:2]
    nb = s // BLOCK
    qb = q.reshape(b, nb, BLOCK, N_KV_HEADS, Q_PER_KV, HEAD_DIM)

    def band(t):
        pad = jnp.zeros((b, BLOCK) + t.shape[2:], t.dtype)
        tb = jnp.concatenate([pad, t], axis=1).reshape((b, nb + 1, BLOCK) + t.shape[2:])
        return jnp.concatenate([tb[:, :-1], tb[:, 1:]], axis=2)

    qi = jnp.arange(BLOCK)[:, None]
    kj = jnp.arange(2 * BLOCK)[None, :]
    diff = BLOCK + qi - kj
    key_pos = (jnp.arange(nb)[:, None, None] - 1) * BLOCK + kj[None]
    mask = (diff >= 0) & (diff < WINDOW) & (key_pos >= 0)
    o = sink_attention(qb, band(k), band(v), mask[:, None, None], sinks)
    return o.reshape(b, s, ATTN_WIDTH)


def attention_sample(q, k, v, ck, cv, sinks):
    b, s = q.shape[:2]
    k_all = jnp.concatenate([ck, k], axis=1)
    v_all = jnp.concatenate([cv, v], axis=1)
    qi = jnp.arange(s)[:, None]
    kj = jnp.arange(WINDOW + s)[None, :]
    diff = WINDOW + qi - kj
    mask = (diff >= 0) & (diff < WINDOW)
    o = sink_attention(q.reshape(b, s, N_KV_HEADS, Q_PER_KV, HEAD_DIM), k_all, v_all, mask, sinks)
    return o.reshape(b, s, ATTN_WIDTH), k_all[:, -WINDOW:], v_all[:, -WINDOW:]


def spatial_gate(u, g, sg_w, sg_b):
    b, s, _ = u.shape
    rows = min(s, CHUNK)
    nc = s // rows
    causal = jnp.tril(jnp.ones((rows, rows), dtype=bool))
    w = jnp.where(causal, sg_w[:, :rows, :rows], 0.0)
    gc = g.reshape(b, nc, rows, N_SG_HEADS, SG_HEAD_DIM)
    mixed = jnp.einsum('hij,bnjhd->bnihd', w, gc) + sg_b[:, :rows].T[:, :, None]
    return u * mixed.reshape(b, s, SG_WIDTH)


def merge_and_ffn(h, a, sgo, attn_out_norm, sg_out_norm, w_o, ffn_norm, w_gate, w_up, w_down):
    mix = jnp.concatenate([rmsnorm(a, attn_out_norm), rmsnorm(sgo, sg_out_norm)], axis=-1)
    h = h + jnp.einsum('bse,ed->bsd', mix, w_o)
    hn = rmsnorm(h, ffn_norm)
    act = jax.nn.silu(jnp.einsum('bsd,df->bsf', hn, w_gate)) * jnp.einsum('bsd,df->bsf', hn, w_up)
    return h + jnp.einsum('bsf,fd->bsd', act, w_down)


def setup_inputs(seed: int = 0) -> dict:
    key = jax.random.key(seed)
    ks = jax.random.split(key, 20)
    f32 = jnp.float32
    L = DEPTH

    def nrm(k, shape, scale=1.0):
        return jax.random.normal(k, shape, f32) * scale

    return {
        "x_prompt": nrm(ks[0], (BATCH, SEQ, D_MODEL)),
        "x_sample": nrm(ks[1], (DEC_BATCH, DEC_SEQ, D_MODEL)),
        "cache_k_win": nrm(ks[2], (L, DEC_BATCH, WINDOW, N_KV_HEADS, HEAD_DIM)),
        "cache_v_win": nrm(ks[3], (L, DEC_BATCH, WINDOW, N_KV_HEADS, HEAD_DIM)),
        "attn_norm": 1.0 + nrm(ks[4], (L, D_MODEL), 0.02),
        "w_in": nrm(ks[5], (L, D_MODEL, IN_WIDTH), D_MODEL ** -0.5),
        "q_norm": 1.0 + nrm(ks[6], (L, HEAD_DIM), 0.02),
        "k_norm": 1.0 + nrm(ks[7], (L, HEAD_DIM), 0.02),
        "sinks": nrm(ks[8], (L, N_Q_HEADS), 0.5),
        "sg_norm": 1.0 + nrm(ks[9], (L, SG_WIDTH), 0.02),
        "sg_w": nrm(ks[10], (L, N_SG_HEADS, CHUNK, CHUNK), CHUNK ** -0.5),
        "sg_b": 1.0 + nrm(ks[11], (L, N_SG_HEADS, CHUNK), 0.1),
        "attn_out_norm": 1.0 + nrm(ks[12], (L, ATTN_WIDTH), 0.02),
        "sg_out_norm": 1.0 + nrm(ks[13], (L, SG_WIDTH), 0.02),
        "w_o": nrm(ks[14], (L, D_MODEL, D_MODEL), D_MODEL ** -0.5),
        "ffn_norm": 1.0 + nrm(ks[15], (L, D_MODEL), 0.02),
        "w_gate": nrm(ks[16], (L, D_MODEL, D_FF), D_MODEL ** -0.5),
        "w_up": nrm(ks[17], (L, D_MODEL, D_FF), D_MODEL ** -0.5),
        "w_down": nrm(ks[18], (L, D_FF, D_MODEL), D_FF ** -0.5),
    }


def reference(x_prompt, x_sample, cache_k_win, cache_v_win, attn_norm, w_in, q_norm, k_norm,
              sinks, sg_norm, sg_w, sg_b, attn_out_norm, sg_out_norm, w_o, ffn_norm,
              w_gate, w_up, w_down):
    pos_p = jnp.arange(x_prompt.shape[1], dtype=jnp.int32)
    pos_s = PAST_LEN + jnp.arange(x_sample.shape[1], dtype=jnp.int32)
    hp, hs = x_prompt, x_sample
    kp_list, vp_list, ks_list, vs_list, gs_list = [], [], [], [], []
    for l in range(DEPTH):
        q, k, v, u, g = project(rmsnorm(hp, attn_norm[l]), pos_p, w_in[l], q_norm[l], k_norm[l], sg_norm[l])
        a = attention_prompt(q, k, v, sinks[l])
        sgo = spatial_gate(u, g, sg_w[l], sg_b[l])
        hp = merge_and_ffn(hp, a, sgo, attn_out_norm[l], sg_out_norm[l], w_o[l], ffn_norm[l],
                           w_gate[l], w_up[l], w_down[l])
        kp_list.append(k[:, -WINDOW:])
        vp_list.append(v[:, -WINDOW:])
        q, k, v, u, g = project(rmsnorm(hs, attn_norm[l]), pos_s, w_in[l], q_norm[l], k_norm[l], sg_norm[l])
        a, k_new, v_new = attention_sample(q, k, v, cache_k_win[l], cache_v_win[l], sinks[l])
        sgo = spatial_gate(u, g, sg_w[l], sg_b[l])
        hs = merge_and_ffn(hs, a, sgo, attn_out_norm[l], sg_out_norm[l], w_o[l], ffn_norm[l],
                           w_gate[l], w_up[l], w_down[l])
        ks_list.append(k_new)
        vs_list.append(v_new)
        gs_list.append(g)
    k_win_prompt = jnp.stack(kp_list)
    v_win_prompt = jnp.stack(vp_list)
    k_win_sample = jnp.stack(ks_list)
    v_win_sample = jnp.stack(vs_list)
    sg_v_sample = jnp.stack(gs_list)
    return (hp, hs, k_win_prompt, v_win_prompt, k_win_sample, v_win_sample, sg_v_sample)
```

```cpp
#include <hip/hip_runtime.h>
#include <hip/hip_cooperative_groups.h>
#include <cstdio>
#include <cstdint>
namespace cg = cooperative_groups;

#define LAS __attribute__((address_space(3)))
typedef unsigned short bf16_t;
typedef short bf16x8 __attribute__((ext_vector_type(8)));
typedef short s16x4 __attribute__((ext_vector_type(4)));
typedef float f32x4 __attribute__((ext_vector_type(4)));
typedef unsigned u32x4 __attribute__((ext_vector_type(4)));
typedef unsigned u32x2 __attribute__((ext_vector_type(2)));

constexpr int DM = 2048, MP = 8192, MS = 1024, MT = MP + MS;
constexpr int INW = 3584, FF = 5632, AW = 1024, SGW = 1024, KVW = 256;
constexpr float EPS = 1e-6f;
constexpr int NROPE = 2056;

constexpr size_t OFF_WIN = 0;
constexpr size_t OFF_WO = OFF_WIN + (size_t)INW * DM * 2;
constexpr size_t OFF_WGU = OFF_WO + (size_t)DM * DM * 2;
constexpr size_t OFF_WDN = OFF_WGU + (size_t)2 * FF * DM * 2;
constexpr size_t OFF_HB = OFF_WDN + (size_t)DM * FF * 2;
constexpr size_t OFF_ROPE = OFF_HB + (size_t)MT * DM * 2;
constexpr size_t OFF_WSG = OFF_ROPE + (size_t)NROPE * 64 * 4;
constexpr size_t OFF_GSS = OFF_WSG + (size_t)8 * 128 * 128 * 2;
constexpr size_t OFF_HSS = OFF_GSS + (size_t)MT * 16 * 4;
constexpr size_t OFF_BAR = OFF_HSS + (size_t)MT * 32 * 4;
constexpr size_t BAR_BYTES = 32768;
constexpr size_t OFF_ACT = OFF_BAR + BAR_BYTES;
constexpr size_t OFF_XN = OFF_ACT;
constexpr size_t OFF_Q = OFF_XN + (size_t)MT * DM * 2;
constexpr size_t OFF_KB = OFF_Q + (size_t)MT * AW * 2;
constexpr size_t OFF_VB = OFF_KB + (size_t)MT * KVW * 2;
constexpr size_t OFF_U = OFF_VB + (size_t)MT * KVW * 2;
constexpr size_t OFF_G = OFF_U + (size_t)MT * SGW * 2;
constexpr size_t OFF_MIX = OFF_G + (size_t)MT * SGW * 2;
constexpr size_t WS_END = OFF_MIX + (size_t)152 * 262144;
static_assert(OFF_ACT + (size_t)MT * FF * 2 <= OFF_MIX, "ACT overlay fits");
static_assert((size_t)256 * 262144 <= OFF_WDN && (size_t)256 * 262144 <= OFF_MIX - OFF_XN, "partial-tile slots overlay only dead buffers");
static_assert(OFF_ACT % 256 == 0 && OFF_ROPE % 256 == 0 && OFF_WSG % 256 == 0, "alignment");

constexpr size_t OUT_Y = 0;
constexpr size_t OUT_KWP = (size_t)MT * DM;
constexpr size_t OUT_VWP = OUT_KWP + 4 * 128 * 256;
constexpr size_t OUT_KWS = OUT_VWP + 4 * 128 * 256;
constexpr size_t OUT_VWS = OUT_KWS + (size_t)128 * 128 * 256;
constexpr size_t OUT_SGV = OUT_VWS + (size_t)128 * 128 * 256;

struct Params {
    const float *x_prompt, *x_sample, *cache_k, *cache_v, *attn_norm, *w_in, *q_norm, *k_norm, *sinks, *sg_norm, *sg_w, *sg_b,
        *attn_out_norm, *sg_out_norm, *w_o, *ffn_norm, *w_gate, *w_up, *w_down;
    float* out; unsigned char* ws;
};

__device__ const double ROPE_INV[32] = {1.0, 0.7498942093324559, 0.5623413251903491, 0.4216965034285822, 0.31622776601683794, 0.23713737056616552, 0.1778279410038923, 0.1333521432163324, 0.1, 0.07498942093324558, 0.05623413251903491, 0.042169650342858224, 0.03162277660168379, 0.023713737056616554, 0.01778279410038923, 0.01333521432163324, 0.01, 0.007498942093324558, 0.005623413251903491, 0.004216965034285823, 0.0031622776601683794, 0.0023713737056616554, 0.0017782794100389228, 0.001333521432163324, 0.001, 0.0007498942093324559, 0.0005623413251903491, 0.00042169650342858224, 0.00031622776601683794, 0.00023713737056616554, 0.00017782794100389227, 0.0001333521432163324};

__device__ __forceinline__ unsigned pk2(float lo, float hi) { unsigned r; asm volatile("v_cvt_pk_bf16_f32 %0, %1, %2" : "=v"(r) : "v"(lo), "v"(hi)); return r; }
__device__ __forceinline__ int opaque(int x) { asm volatile("" : "+v"(x)); return x; }
__device__ __forceinline__ float bf_lo(unsigned w) { return __builtin_bit_cast(float, w << 16); }
__device__ __forceinline__ float bf_hi(unsigned w) { return __builtin_bit_cast(float, w & 0xffff0000u); }
__device__ __forceinline__ float gelu_tanh(float x) {
    const float y = 1.5957691216057308f * (x + 0.044715f * x * x * x);
    return x * __builtin_amdgcn_rcpf(1.0f + __expf(-y));
}
typedef float f32x2 __attribute__((ext_vector_type(2)));
__device__ __forceinline__ f32x2 gelu2(f32x2 x) {
    const f32x2 t = ((x * x) * 0.044715f + 1.0f) * x;
    const f32x2 z = t * (-1.5957691216057308f * 1.4426950408889634f);
    f32x2 e; e.x = __builtin_amdgcn_exp2f(z.x); e.y = __builtin_amdgcn_exp2f(z.y);
    const f32x2 d = e + 1.0f;
    f32x2 r; r.x = __builtin_amdgcn_rcpf(d.x); r.y = __builtin_amdgcn_rcpf(d.y);
    return x * r;
}
__device__ __forceinline__ f32x2 silu_mul2(f32x2 g, f32x2 u) {
    const f32x2 z = g * (-1.4426950408889634f);
    f32x2 e; e.x = __builtin_amdgcn_exp2f(z.x); e.y = __builtin_amdgcn_exp2f(z.y);
    const f32x2 d = e + 1.0f;
    f32x2 r; r.x = __builtin_amdgcn_rcpf(d.x); r.y = __builtin_amdgcn_rcpf(d.y);
    return (g * r) * u;
}
__device__ __forceinline__ float silu(float x) { return x * __builtin_amdgcn_rcpf(1.0f + __expf(-x)); }
__device__ __forceinline__ float wave_sum(float v) {
#pragma unroll
    for (int o = 1; o < 64; o <<= 1) v += __shfl_xor(v, o);
    return v;
}
__device__ __forceinline__ float fq_sum(float v) { v += __shfl_xor(v, 16); v += __shfl_xor(v, 32); return v; }
__device__ __forceinline__ float fq_max(float v) { v = fmaxf(v, __shfl_xor(v, 16)); v = fmaxf(v, __shfl_xor(v, 32)); return v; }
__device__ __forceinline__ const float* xrow(const Params& p, int row) { return row < MP ? p.x_prompt + (size_t)row * DM : p.x_sample + (size_t)(row - MP) * DM; }

namespace pg8 {
constexpr int BM = 256, BK = 64, HALF = 128, HTB = HALF * BK * 2, STAGE_BYTES = 8 * HTB, NXCD = 8, WGM = 8;
__host__ __device__ __forceinline__ int lds_byte(int r, int c) { const int st = (r >> 4) * 2 + (c >> 5), rr = r & 15, cc = c & 31, ob = rr * 64 + cc * 2; return st * 1024 + (ob ^ (((ob >> 9) & 1) << 5)); }
__host__ __device__ __forceinline__ void stage_rc(int b, int& R, int& C) { const int st = b / 1024, sb = b % 1024, swz = sb ^ (((sb >> 9) & 1) << 5); R = (st >> 1) * 16 + swz / 64; C = (st & 1) * 32 + (swz % 64) / 2; }
struct Unit { int pm, pn, kt0, nkt, sq, sj, sf; };
struct Gemm { const bf16_t* A; const bf16_t* Bt; int M, N, K; };
struct TailSplitOrder {
    int nM, nN, nwg, G, c, ntk, nfull, rem, sf;
    __device__ void init(int M, int N, int K, int G_, int c_, int maxsf = 8) {
        nM = M / BM; nN = N / BM; nwg = nM * nN; G = G_; c = c_; ntk = K / BK; nfull = nwg / G; rem = nwg % G;
        sf = rem ? G / rem : 1; if (sf > ntk / 2) sf = ntk / 2; if (sf > maxsf) sf = maxsf; if (sf < 2) sf = 1;
    }
    __device__ void tile(int L, Unit& u) const {
        int wgid = L; { const int q = nwg / NXCD, r = nwg % NXCD, xcd = wgid % NXCD, off = wgid / NXCD; wgid = (xcd < r ? xcd * (q + 1) : r * (q + 1) + (xcd - r) * q) + off; }
        const int nig = WGM * nN, gid = wgid / nig, fm = gid * WGM, gsz = (nM - fm) < WGM ? (nM - fm) : WGM;
        u.pm = fm + ((wgid % nig) % gsz); u.pn = (wgid % nig) / gsz;
    }
    __device__ bool next(int i, Unit& u) const {
        u.kt0 = 0; u.nkt = ntk; u.sq = 0; u.sj = 0; u.sf = 1;
        if (i < nfull) { tile(i * G + c, u); return true; }
        if (i > nfull || rem == 0) return false;
        if (sf == 1) { if (c >= rem) return false; tile(nfull * G + c, u); return true; }
        const int q = c / sf, j = c % sf; if (q >= rem) return false;
        tile(nfull * G + q, u);
        const int pp = ntk / 2, a = pp * j / sf, b = pp * (j + 1) / sf;
        u.kt0 = 2 * a; u.nkt = 2 * (b - a); u.sq = q; u.sj = j; u.sf = sf; return true;
    }
};
struct SplitCtx { float* part0; int n0; float* part1; unsigned* ctr; };
template <class Epi, class Sched>
__device__ __forceinline__ void gemm_phase(LAS unsigned char* lds, const Gemm g, const Sched& S, const Epi& E, const SplitCtx sc) {
    const int tid = opaque(threadIdx.x), wid = __builtin_amdgcn_readfirstlane(tid >> 6), lane = tid & 63, wr = wid >> 2, wc = wid & 3, fr = lane & 15, fq = lane >> 4;
    const int K = g.K;
    unsigned voffA[2];
#pragma unroll
    for (int i = 0; i < 2; ++i) { int R, C; stage_rc(tid * 16 + i * 8192, R, C); voffA[i] = (unsigned)(R * K + C) * 2u; }
    const size_t kstep = (size_t)(BK * 2);
    const size_t hstep = (size_t)HALF * K * 2;
    const size_t tstep = 2 * hstep;
    const unsigned ldsw = (unsigned)wid * 1024u;
    const int aoff = lds_byte(wr * 64 + fr, fq * 8), boff = lds_byte(wc * 32 + fr, fq * 8);
#define PG8_SA(b, h) (((b) * 2 + (h)) * HTB)
#define PG8_SB(b, h) ((4 + (b) * 2 + (h)) * HTB)
#define PG8_STAGE(bufoff, gbase) do { _Pragma("unroll") for (int _i = 0; _i < 2; ++_i) \
        __builtin_amdgcn_global_load_lds((const unsigned*)((const char*)(gbase) + voffA[_i]), (LAS unsigned*)(lds + (bufoff) + ldsw + _i * 8192), 16, 0, 0); } while (0)
#define PG8_LDA(dst, b, h) do { _Pragma("unroll") for (int m = 0; m < 4; ++m) _Pragma("unroll") for (int k = 0; k < 2; ++k) dst[m][k] = *(const LAS bf16x8*)(lds + PG8_SA(b, h) + aoff + m * 2048 + k * 1024); } while (0)
#define PG8_LDB(dst, b, h) do { _Pragma("unroll") for (int n = 0; n < 2; ++n) _Pragma("unroll") for (int k = 0; k < 2; ++k) dst[n][k] = *(const LAS bf16x8*)(lds + PG8_SB(b, h) + boff + n * 2048 + k * 1024); } while (0)
#define PG8_MMA(ai, bj, At, Bt) do { __builtin_amdgcn_s_setprio(1); _Pragma("unroll") for (int m = 0; m < 4; ++m) _Pragma("unroll") for (int n = 0; n < 2; ++n) _Pragma("unroll") for (int k = 0; k < 2; ++k) \
        acc[ai][bj][m][n] = __builtin_amdgcn_mfma_f32_16x16x32_bf16(Bt[n][k], At[m][k], acc[ai][bj][m][n], 0, 0, 0); __builtin_amdgcn_s_setprio(0); } while (0)
#define PG8_WAIT_V(n) asm volatile("s_waitcnt vmcnt(" #n ")" ::: "memory")
#define PG8_WAIT_L(n) asm volatile("s_waitcnt lgkmcnt(" #n ")" ::: "memory")
#define PG8_BAR __builtin_amdgcn_s_barrier()
#define PG8_SCHED __builtin_amdgcn_sched_barrier(0)
    Unit cur, nxt; int ui = 0;
    if (!S.next(0, cur)) return;
    f32x4 acc[2][2][4][2];
#pragma unroll
    for (int a = 0; a < 2; ++a)
#pragma unroll
        for (int b = 0; b < 2; ++b)
#pragma unroll
            for (int m = 0; m < 4; ++m)
#pragma unroll
                for (int n = 0; n < 2; ++n) acc[a][b][m][n] = (f32x4){0.f, 0.f, 0.f, 0.f};
    bf16x8 At[4][2], B0[2][2], B1[2][2];
    const char* cA = (const char*)g.A + (size_t)cur.pm * tstep + (size_t)cur.kt0 * kstep; const char* cB = (const char*)g.Bt + (size_t)cur.pn * tstep + (size_t)cur.kt0 * kstep;
    PG8_STAGE(PG8_SB(0, 0), cB); PG8_STAGE(PG8_SB(0, 1), cB + hstep); PG8_STAGE(PG8_SA(0, 0), cA); PG8_STAGE(PG8_SA(0, 1), cA + hstep);
    if (wr == 1) PG8_BAR;
    PG8_WAIT_V(2); PG8_BAR;
    PG8_STAGE(PG8_SB(1, 0), cB + kstep); PG8_STAGE(PG8_SA(1, 0), cA + kstep); PG8_STAGE(PG8_SB(1, 1), cB + hstep + kstep);
    PG8_WAIT_V(6); PG8_BAR;
    for (;;) {
        const bool has_next = S.next(ui + 1, nxt);
        const char* nA = has_next ? (const char*)g.A + (size_t)nxt.pm * tstep + (size_t)nxt.kt0 * kstep : cA; const char* nB = has_next ? (const char*)g.Bt + (size_t)nxt.pn * tstep + (size_t)nxt.kt0 * kstep : cB;
        const int nt = cur.nkt;
        for (int t = 0; t < nt; t += 2) {
            const bool last = (t == nt - 2);
            const char* a1 = cA + (size_t)(t + 1) * kstep;
            const char* a2 = last ? nA : cA + (size_t)(t + 2) * kstep; const char* b2 = last ? nB : cB + (size_t)(t + 2) * kstep;
            const char* a3 = a2 + kstep; const char* b3 = b2 + kstep;
            PG8_LDB(B0, 0, 0); PG8_LDB(B1, 0, 1); PG8_SCHED; PG8_LDA(At, 0, 0); PG8_STAGE(PG8_SA(1, 1), a1 + hstep);
            PG8_WAIT_V(8); PG8_WAIT_L(0); PG8_BAR; PG8_MMA(0, 0, At, B0); PG8_MMA(0, 1, At, B1); PG8_BAR; PG8_SCHED;
            PG8_LDA(At, 0, 1); PG8_STAGE(PG8_SB(0, 0), b2); PG8_STAGE(PG8_SB(0, 1), b2 + hstep); PG8_STAGE(PG8_SA(0, 0), a2);
            PG8_WAIT_V(8); PG8_WAIT_L(0); PG8_BAR; PG8_MMA(1, 0, At, B0); PG8_MMA(1, 1, At, B1); PG8_BAR; PG8_SCHED;
            PG8_LDB(B0, 1, 0); PG8_LDB(B1, 1, 1); PG8_SCHED; PG8_LDA(At, 1, 0); PG8_STAGE(PG8_SA(0, 1), a2 + hstep);
            PG8_WAIT_V(8); PG8_WAIT_L(0); PG8_BAR; PG8_MMA(0, 0, At, B0); PG8_MMA(0, 1, At, B1); PG8_BAR; PG8_SCHED;
            PG8_LDA(At, 1, 1); PG8_STAGE(PG8_SB(1, 0), b3); PG8_STAGE(PG8_SB(1, 1), b3 + hstep); PG8_STAGE(PG8_SA(1, 0), a3);
            PG8_WAIT_V(8); PG8_WAIT_L(0); PG8_BAR; PG8_MMA(1, 0, At, B0); PG8_MMA(1, 1, At, B1); PG8_BAR; PG8_SCHED;
        }
        if (wr == 0) PG8_BAR;
        int rg0 = 0, rg1 = 8;
        if (cur.sf > 1) {
            {
                const int si = cur.sq * cur.sf + cur.sj;
                u32x4* slot = (u32x4*)((si < sc.n0 ? sc.part0 + (size_t)si * 65536 : sc.part1 + (size_t)(si - sc.n0) * 65536)) + tid;
#pragma unroll
                for (int a = 0; a < 2; ++a)
#pragma unroll
                    for (int m = 0; m < 4; ++m)
#pragma unroll
                        for (int b = 0; b < 2; ++b) {
                            const f32x4 v0 = acc[a][b][m][0], v1 = acc[a][b][m][1];
                            u32x4 w; w.x = pk2(v0[0], v0[1]); w.y = pk2(v0[2], v0[3]); w.z = pk2(v1[0], v1[1]); w.w = pk2(v1[2], v1[3]);
                            *slot = w; slot += 512; asm volatile("" : "+v"(slot));
                        }
            }
            asm volatile("s_waitcnt vmcnt(0)" ::: "memory");
            __syncthreads();
            if (tid == 0) {
                __builtin_amdgcn_fence(__ATOMIC_RELEASE, "agent");
                asm volatile("s_waitcnt vmcnt(0)" ::: "memory");
                unsigned* cw = sc.ctr + 16 * cur.sq;
                (void)__hip_atomic_fetch_add(cw, 1u, __ATOMIC_RELAXED, __HIP_MEMORY_SCOPE_AGENT);
                unsigned sp = 0;
                while (__hip_atomic_load(cw, __ATOMIC_RELAXED, __HIP_MEMORY_SCOPE_AGENT) < (unsigned)cur.sf) { __builtin_amdgcn_s_sleep(1); if (++sp > (1u << 22)) break; }
                __builtin_amdgcn_fence(__ATOMIC_ACQUIRE, "agent");
                asm volatile("s_waitcnt vmcnt(0)" ::: "memory");
            }
            __syncthreads();
            rg0 = 8 * cur.sj / cur.sf; rg1 = 8 * (cur.sj + 1) / cur.sf;
#pragma unroll
            for (int a = 0; a < 2; ++a)
#pragma unroll
                for (int m = 0; m < 4; ++m) {
                    if (a * 4 + m < rg0 || a * 4 + m >= rg1) continue;
                    f32x4 t00 = (f32x4){0.f, 0.f, 0.f, 0.f}, t01 = t00, t10 = t00, t11 = t00;
#pragma unroll 2
                    for (int j = 0; j < cur.sf; ++j) {
                        const int si = cur.sq * cur.sf + j;
                        const u32x4* slot = (const u32x4*)((si < sc.n0 ? sc.part0 + (size_t)si * 65536 : sc.part1 + (size_t)(si - sc.n0) * 65536)) + tid + (size_t)(a * 4 + m) * 1024;
                        const u32x4 w0 = slot[0], w1 = slot[512];
                        t00 += (f32x4){bf_lo(w0.x), bf_hi(w0.x), bf_lo(w0.y), bf_hi(w0.y)}; t01 += (f32x4){bf_lo(w0.z), bf_hi(w0.z), bf_lo(w0.w), bf_hi(w0.w)};
                        t10 += (f32x4){bf_lo(w1.x), bf_hi(w1.x), bf_lo(w1.y), bf_hi(w1.y)}; t11 += (f32x4){bf_lo(w1.z), bf_hi(w1.z), bf_lo(w1.w), bf_hi(w1.w)};
                    }
                    acc[a][0][m][0] = t00; acc[a][0][m][1] = t01; acc[a][1][m][0] = t10; acc[a][1][m][1] = t11;
                }
        }
        E(acc, cur, wr, wc, fr, fq, rg0, rg1);
        if (!has_next) break;
#pragma unroll
        for (int a = 0; a < 2; ++a)
#pragma unroll
            for (int b = 0; b < 2; ++b)
#pragma unroll
                for (int m = 0; m < 4; ++m)
#pragma unroll
                    for (int n = 0; n < 2; ++n) acc[a][b][m][n] = (f32x4){0.f, 0.f, 0.f, 0.f};
        cur = nxt; cA = nA; cB = nB; ++ui;
        if (wr == 1) PG8_BAR;
    }
    PG8_WAIT_V(0);
    PG8_BAR;
#undef PG8_SA
#undef PG8_SB
#undef PG8_STAGE
#undef PG8_LDA
#undef PG8_LDB
#undef PG8_MMA
#undef PG8_WAIT_V
#undef PG8_WAIT_L
#undef PG8_BAR
#undef PG8_SCHED
}
}
using pg8::Unit;

typedef f32x4 Acc[2][2][4][2];

struct EpiProj {
    bf16_t *Q, *Kb, *Vb, *U, *G; float* gss; const float* rope; const float *qn, *kn; float* out;
    __device__ __forceinline__ void operator()(const Acc& acc, const Unit& u, int wr, int wc, int fr, int fq, int rg0, int rg1) const {
        const int pn = u.pn;
        const int rbase = u.pm * 256 + wr * 64 + fr;
        if (pn < 5) {
            const bool isq = pn < 4;
            const float* nw = (isq ? qn : kn) + 8 * fq;
            const f32x4 w00 = *(const f32x4*)(nw), w01 = *(const f32x4*)(nw + 4), w10 = *(const f32x4*)(nw + 32), w11 = *(const f32x4*)(nw + 36);
            const float osc = isq ? 0.125f : 1.0f;
#pragma unroll
            for (int ai = 0; ai < 2; ++ai)
#pragma unroll
                for (int m = 0; m < 4; ++m) {
                if (ai * 4 + m < rg0 || ai * 4 + m >= rg1) continue;
                    if (ai * 4 + m < rg0 || ai * 4 + m >= rg1) continue;
                    const int row = rbase + ai * 128 + m * 16;
                    float ss = 0.f;
#pragma unroll
                    for (int bj = 0; bj < 2; ++bj)
#pragma unroll
                        for (int n = 0; n < 2; ++n) { const f32x4 v = acc[ai][bj][m][n]; ss += (v[0] * v[0] + v[1] * v[1]) + (v[2] * v[2] + v[3] * v[3]); }
                    ss = fq_sum(ss);
                    const float r = rsqrtf(ss * (1.0f / 64.0f) + EPS);
                    const int pidx = row < MP ? (row & 2047) : 2048 + (row & 7);
                    const float* rp = rope + pidx * 64 + 8 * fq;
                    const f32x4 c0 = *(const f32x4*)(rp), c1 = *(const f32x4*)(rp + 4), s0 = *(const f32x4*)(rp + 32), s1 = *(const f32x4*)(rp + 36);
                    const f32x4 x10 = acc[ai][0][m][0] * w00 * r, x11 = acc[ai][0][m][1] * w01 * r, x20 = acc[ai][1][m][0] * w10 * r, x21 = acc[ai][1][m][1] * w11 * r;
                    const f32x4 o10 = (x10 * c0 - x20 * s0) * osc, o11 = (x11 * c1 - x21 * s1) * osc, o20 = (x20 * c0 + x10 * s0) * osc, o21 = (x21 * c1 + x11 * s1) * osc;
                    u32x4 lo, hi;
                    lo.x = pk2(o10[0], o10[1]); lo.y = pk2(o10[2], o10[3]); lo.z = pk2(o11[0], o11[1]); lo.w = pk2(o11[2], o11[3]);
                    hi.x = pk2(o20[0], o20[1]); hi.y = pk2(o20[2], o20[3]); hi.z = pk2(o21[0], o21[1]); hi.w = pk2(o21[2], o21[3]);
                    if (isq) {
                        bf16_t* d = Q + (size_t)row * AW + (4 * pn + wc) * 64 + 8 * fq;
                        *(u32x4*)d = lo; *(u32x4*)(d + 32) = hi;
                    } else {
                        bf16_t* d = Kb + (size_t)row * KVW + wc * 64 + 8 * fq;
                        *(u32x4*)d = lo; *(u32x4*)(d + 32) = hi;
                        float* wdst = nullptr;
                        if (row >= MP) { const int rr = row - MP; wdst = out + OUT_KWS + ((size_t)((rr >> 3) * 128 + 120 + (rr & 7)) * 4 + wc) * 64 + 8 * fq; }
                        else if ((row & 2047) >= 1920) wdst = out + OUT_KWP + ((size_t)((row >> 11) * 128 + (row & 2047) - 1920) * 4 + wc) * 64 + 8 * fq;
                        if (wdst) { *(f32x4*)wdst = o10; *(f32x4*)(wdst + 4) = o11; *(f32x4*)(wdst + 32) = o20; *(f32x4*)(wdst + 36) = o21; }
                    }
                }
        } else if (pn == 5) {
#pragma unroll
            for (int ai = 0; ai < 2; ++ai)
#pragma unroll
                for (int m = 0; m < 4; ++m) {
                if (ai * 4 + m < rg0 || ai * 4 + m >= rg1) continue;
                    if (ai * 4 + m < rg0 || ai * 4 + m >= rg1) continue;
                    const int row = rbase + ai * 128 + m * 16;
                    float* wdst = nullptr;
                    if (row >= MP) { const int rr = row - MP; wdst = out + OUT_VWS + ((size_t)((rr >> 3) * 128 + 120 + (rr & 7)) * 4 + wc) * 64 + 8 * fq; }
                    else if ((row & 2047) >= 1920) wdst = out + OUT_VWP + ((size_t)((row >> 11) * 128 + (row & 2047) - 1920) * 4 + wc) * 64 + 8 * fq;
#pragma unroll
                    for (int bj = 0; bj < 2; ++bj) {
                        const f32x4 v0 = acc[ai][bj][m][0], v1 = acc[ai][bj][m][1];
                        u32x4 w; w.x = pk2(v0[0], v0[1]); w.y = pk2(v0[2], v0[3]); w.z = pk2(v1[0], v1[1]); w.w = pk2(v1[2], v1[3]);
                        *(u32x4*)(Vb + (size_t)row * KVW + wc * 64 + 32 * bj + 8 * fq) = w;
                        if (wdst) { *(f32x4*)(wdst + 32 * bj) = v0; *(f32x4*)(wdst + 32 * bj + 4) = v1; }
                    }
                }
        } else {
            const bool isg = pn >= 10;
            bf16_t* dst = isg ? G : U; const int ct = isg ? pn - 10 : pn - 6;
#pragma unroll
            for (int ai = 0; ai < 2; ++ai)
#pragma unroll
                for (int m = 0; m < 4; ++m) {
                if (ai * 4 + m < rg0 || ai * 4 + m >= rg1) continue;
                    if (ai * 4 + m < rg0 || ai * 4 + m >= rg1) continue;
                    const int row = rbase + ai * 128 + m * 16;
                    float ss = 0.f;
#pragma unroll
                    for (int bj = 0; bj < 2; ++bj) {
                        f32x4 v0 = acc[ai][bj][m][0], v1 = acc[ai][bj][m][1];
                        { const f32x2 a = gelu2((f32x2){v0[0], v0[1]}), b2 = gelu2((f32x2){v0[2], v0[3]}), c2 = gelu2((f32x2){v1[0], v1[1]}), d2 = gelu2((f32x2){v1[2], v1[3]});
                          v0 = (f32x4){a.x, a.y, b2.x, b2.y}; v1 = (f32x4){c2.x, c2.y, d2.x, d2.y}; }
                        ss += (v0[0] * v0[0] + v0[1] * v0[1]) + (v0[2] * v0[2] + v0[3] * v0[3]) + (v1[0] * v1[0] + v1[1] * v1[1]) + (v1[2] * v1[2] + v1[3] * v1[3]);
                        u32x4 w; w.x = pk2(v0[0], v0[1]); w.y = pk2(v0[2], v0[3]); w.z = pk2(v1[0], v1[1]); w.w = pk2(v1[2], v1[3]);
                        *(u32x4*)(dst + (size_t)row * SGW + ct * 256 + wc * 64 + 32 * bj + 8 * fq) = w;
                    }
                    if (isg) { ss = fq_sum(ss); if (fq == 0) gss[(size_t)row * 16 + ct * 4 + wc] = ss; }
                }
        }
    }
};

struct EpiWo {
    Params p; bf16_t* HB; float* hss;
    __device__ __forceinline__ void operator()(const Acc& acc, const Unit& u, int wr, int wc, int fr, int fq, int rg0, int rg1) const {
        const int rbase = u.pm * 256 + wr * 64 + fr, cb = u.pn * 256 + wc * 64 + 8 * fq;
#pragma unroll
        for (int ai = 0; ai < 2; ++ai)
#pragma unroll
        for (int mh = 0; mh < 2; ++mh) {
            f32x4 xv[4][2][2];
#pragma unroll
            for (int m = 2 * mh; m < 2 * mh + 2; ++m) {
                if (ai * 4 + m < rg0 || ai * 4 + m >= rg1) continue;
                const float* xr = xrow(p, rbase + ai * 128 + m * 16) + cb;
#pragma unroll
                for (int bj = 0; bj < 2; ++bj) { xv[m][bj][0] = *(const f32x4*)(xr + 32 * bj); xv[m][bj][1] = *(const f32x4*)(xr + 32 * bj + 4); }
            }
#pragma unroll
            for (int m = 2 * mh; m < 2 * mh + 2; ++m) {
                if (ai * 4 + m < rg0 || ai * 4 + m >= rg1) continue;
                const int row = rbase + ai * 128 + m * 16;
                float ss = 0.f;
#pragma unroll
                for (int bj = 0; bj < 2; ++bj) {
                    const f32x4 h0 = xv[m][bj][0] + acc[ai][bj][m][0], h1 = xv[m][bj][1] + acc[ai][bj][m][1];
                    ss += (h0[0] * h0[0] + h0[1] * h0[1]) + (h0[2] * h0[2] + h0[3] * h0[3]) + (h1[0] * h1[0] + h1[1] * h1[1]) + (h1[2] * h1[2] + h1[3] * h1[3]);
                    u32x4 w; w.x = pk2(h0[0], h0[1]); w.y = pk2(h0[2], h0[3]); w.z = pk2(h1[0], h1[1]); w.w = pk2(h1[2], h1[3]);
                    *(u32x4*)(HB + (size_t)row * DM + cb + 32 * bj) = w;
                }
                ss = fq_sum(ss);
                if (fq == 0) hss[(size_t)row * 32 + u.pn * 4 + wc] = ss;
            }
        }
    }
};

struct EpiGU {
    const float* hss; bf16_t* ACT;
    __device__ __forceinline__ void operator()(const Acc& acc, const Unit& u, int wr, int wc, int fr, int fq, int rg0, int rg1) const {
        const int rbase = u.pm * 256 + wr * 64 + fr, cb = u.pn * 128 + wc * 32 + 8 * fq;
        float r8[8];
#pragma unroll
        for (int ai = 0; ai < 2; ++ai)
#pragma unroll
            for (int m = 0; m < 4; ++m) {
                r8[ai * 4 + m] = 0.f;
                if (ai * 4 + m < rg0 || ai * 4 + m >= rg1) continue;
                const f32x4* hp = (const f32x4*)(hss + (size_t)(rbase + ai * 128 + m * 16) * 32) + 2 * fq;
                const f32x4 t = hp[0] + hp[1];
                r8[ai * 4 + m] = (t[0] + t[1]) + (t[2] + t[3]);
            }
#pragma unroll
        for (int ai = 0; ai < 2; ++ai)
#pragma unroll
            for (int m = 0; m < 4; ++m) {
                if (ai * 4 + m < rg0 || ai * 4 + m >= rg1) continue;
                const int row = rbase + ai * 128 + m * 16;
                const float r = rsqrtf(fq_sum(r8[ai * 4 + m]) * (1.0f / DM) + EPS);
                const f32x4 g0 = acc[ai][0][m][0] * r, g1 = acc[ai][0][m][1] * r, u0 = acc[ai][1][m][0] * r, u1 = acc[ai][1][m][1] * r;
                const f32x2 p0 = silu_mul2((f32x2){g0[0], g0[1]}, (f32x2){u0[0], u0[1]}), p1 = silu_mul2((f32x2){g0[2], g0[3]}, (f32x2){u0[2], u0[3]});
                const f32x2 p2 = silu_mul2((f32x2){g1[0], g1[1]}, (f32x2){u1[0], u1[1]}), p3 = silu_mul2((f32x2){g1[2], g1[3]}, (f32x2){u1[2], u1[3]});
                const f32x4 a0 = (f32x4){p0.x, p0.y, p1.x, p1.y}, a1 = (f32x4){p2.x, p2.y, p3.x, p3.y};
                u32x4 w; w.x = pk2(a0[0], a0[1]); w.y = pk2(a0[2], a0[3]); w.z = pk2(a1[0], a1[1]); w.w = pk2(a1[2], a1[3]);
                *(u32x4*)(ACT + (size_t)row * FF + cb) = w;
            }
    }
};

struct EpiDown {
    float* out; const bf16_t* HB;
    __device__ __forceinline__ void operator()(const Acc& acc, const Unit& u, int wr, int wc, int fr, int fq, int rg0, int rg1) const {
        const int rbase = u.pm * 256 + wr * 64 + fr, cb = u.pn * 256 + wc * 64 + 8 * fq;
#pragma unroll
        for (int ai = 0; ai < 2; ++ai) {
            u32x4 hv[4][2];
#pragma unroll
            for (int m = 0; m < 4; ++m) {
                if (ai * 4 + m < rg0 || ai * 4 + m >= rg1) continue;
                const bf16_t* hr = HB + (size_t)(rbase + ai * 128 + m * 16) * DM + cb;
#pragma unroll
                for (int bj = 0; bj < 2; ++bj) hv[m][bj] = *(const u32x4*)(hr + 32 * bj);
            }
#pragma unroll
            for (int m = 0; m < 4; ++m) {
                if (ai * 4 + m < rg0 || ai * 4 + m >= rg1) continue;
                float* yr = out + OUT_Y + (size_t)(rbase + ai * 128 + m * 16) * DM + cb;
#pragma unroll
                for (int bj = 0; bj < 2; ++bj) {
                    const u32x4 w = hv[m][bj];
                    const f32x4 h0 = (f32x4){bf_lo(w.x), bf_hi(w.x), bf_lo(w.y), bf_hi(w.y)}, h1 = (f32x4){bf_lo(w.z), bf_hi(w.z), bf_lo(w.w), bf_hi(w.w)};
                    __builtin_nontemporal_store(h0 + acc[ai][bj][m][0], (f32x4*)(yr + 32 * bj)); __builtin_nontemporal_store(h1 + acc[ai][bj][m][1], (f32x4*)(yr + 32 * bj + 4));
                }
            }
        }
    }
};

__device__ __forceinline__ void p0_transpose_item(const float* W, int K, int N, bf16_t* WT, int mode, const float* s0, const float* s1, int split,
                                                  LAS float* scr, int item, int lane) {
    const int nblk = N / 32, kb = item / nblk, nb = item % nblk, k0 = 64 * kb, n0 = 32 * nb;
#pragma unroll 8
    for (int i = 0; i < 32; ++i) { const int kk = 2 * i + (lane >> 5); scr[kk * 33 + (lane & 31)] = __builtin_nontemporal_load(W + (size_t)(k0 + kk) * N + n0 + (lane & 31)); }
    asm volatile("s_waitcnt lgkmcnt(0)" ::: "memory");
    const int c = lane & 7;
    float sc[8];
#pragma unroll
    for (int e = 0; e < 8; ++e) { const int k = k0 + 8 * c + e; sc[e] = s0 ? (k < split ? s0[k] : s1[k - split]) : 1.0f; }
    int rowbase;
    if (mode == 0) rowbase = (n0 >> 8) * 256 + ((n0 >> 5) & 1) * 128 + ((n0 >> 6) & 3) * 32;
    else rowbase = (n0 >> 7) * 256 + (mode - 1) * 128 + ((n0 >> 5) & 3) * 32;
#pragma unroll
    for (int j = 0; j < 4; ++j) {
        const int n = (lane >> 3) + 8 * j; const LAS float* s = scr + (8 * c) * 33 + n;
        const int pr = 16 * ((n >> 2) & 1) + 4 * (n >> 3) + (n & 3);
        u32x4 o; o.x = pk2(s[0 * 33] * sc[0], s[1 * 33] * sc[1]); o.y = pk2(s[2 * 33] * sc[2], s[3 * 33] * sc[3]); o.z = pk2(s[4 * 33] * sc[4], s[5 * 33] * sc[5]); o.w = pk2(s[6 * 33] * sc[6], s[7 * 33] * sc[7]);
        *(u32x4*)(WT + (size_t)(rowbase + pr) * K + k0 + 8 * c) = o;
    }
    asm volatile("s_waitcnt lgkmcnt(0)" ::: "memory");
}

__device__ __forceinline__ void sincos_pi(double r, double& s, double& c) {
    const double x2 = r * r;
    double ps = -1.0 / 1.0888869450418352e28;
    ps = ps * x2 + 1.0 / 1.5511210043330986e25;
    ps = ps * x2 - 1.0 / 2.585201673888498e22;
    ps = ps * x2 + 1.0 / 5.109094217170944e19;
    ps = ps * x2 - 1.0 / 1.21645100408832e17;
    ps = ps * x2 + 1.0 / 3.55687428096e14;
    ps = ps * x2 - 1.0 / 1.307674368e12;
    ps = ps * x2 + 1.0 / 6.2270208e9;
    ps = ps * x2 - 1.0 / 3.99168e7;
    ps = ps * x2 + 1.0 / 362880.0;
    ps = ps * x2 - 1.0 / 5040.0;
    ps = ps * x2 + 1.0 / 120.0;
    ps = ps * x2 - 1.0 / 6.0;
    ps = ps * x2 + 1.0;
    s = ps * r;
    double pc = -1.0 / 4.0329146112660565e26;
    pc = pc * x2 + 1.0 / 6.204484017332394e23;
    pc = pc * x2 - 1.0 / 1.1240007277776077e21;
    pc = pc * x2 + 1.0 / 2.43290200817664e18;
    pc = pc * x2 - 1.0 / 6.402373705728e15;
    pc = pc * x2 + 1.0 / 2.0922789888e13;
    pc = pc * x2 - 1.0 / 8.71782912e10;
    pc = pc * x2 + 1.0 / 4.790016e8;
    pc = pc * x2 - 1.0 / 3628800.0;
    pc = pc * x2 + 1.0 / 40320.0;
    pc = pc * x2 - 1.0 / 720.0;
    pc = pc * x2 + 1.0 / 24.0;
    pc = pc * x2 - 0.5;
    pc = pc * x2 + 1.0;
    c = pc;
}

__device__ __forceinline__ void p0_prologue(const Params& p, LAS unsigned char* lds) {
    const int tid = opaque(threadIdx.x), lane = tid & 63, wave = __builtin_amdgcn_readfirstlane(tid >> 6);
    unsigned char* ws = p.ws;
    const int G = gridDim.x, gw = blockIdx.x * 8 + wave, NGW = G * 8;
    LAS float* scr = (LAS float*)(lds + wave * 16384);
    constexpr int I_IN = (DM / 64) * (INW / 32), I_O = (DM / 64) * (DM / 32), I_G = (DM / 64) * (FF / 32), I_D = (FF / 64) * (DM / 32);
    constexpr int NITEMS = I_IN + I_O + 2 * I_G + I_D;
    for (int it = gw; it < NITEMS; it += NGW) {
        int r = it;
        if (r < I_IN) { p0_transpose_item(p.w_in, DM, INW, (bf16_t*)(ws + OFF_WIN), 0, nullptr, nullptr, 0, scr, r, lane); continue; } r -= I_IN;
        if (r < I_O) { p0_transpose_item(p.w_o, DM, DM, (bf16_t*)(ws + OFF_WO), 0, p.attn_out_norm, p.sg_out_norm, AW, scr, r, lane); continue; } r -= I_O;
        if (r < I_G) { p0_transpose_item(p.w_gate, DM, FF, (bf16_t*)(ws + OFF_WGU), 1, p.ffn_norm, p.ffn_norm, DM, scr, r, lane); continue; } r -= I_G;
        if (r < I_G) { p0_transpose_item(p.w_up, DM, FF, (bf16_t*)(ws + OFF_WGU), 2, p.ffn_norm, p.ffn_norm, DM, scr, r, lane); continue; } r -= I_G;
        p0_transpose_item(p.w_down, FF, DM, (bf16_t*)(ws + OFF_WDN), 0, nullptr, nullptr, 0, scr, r, lane);
    }
    bf16_t* XN = (bf16_t*)(ws + OFF_XN);
    for (int m = gw; m < MT; m += NGW) {
        const f32x4* xr = (const f32x4*)xrow(p, m) + lane;
        f32x4 v[8]; float s = 0.f;
#pragma unroll
        for (int j = 0; j < 8; ++j) { v[j] = xr[64 * j]; s += (v[j][0] * v[j][0] + v[j][1] * v[j][1]) + (v[j][2] * v[j][2] + v[j][3] * v[j][3]); }
        const float r = rsqrtf(wave_sum(s) * (1.0f / DM) + EPS);
        u32x2* o8 = (u32x2*)(XN + (size_t)m * DM) + lane;
#pragma unroll
        for (int j = 0; j < 8; ++j) { const f32x4 w = ((const f32x4*)p.attn_norm)[lane + 64 * j]; const f32x4 y = v[j] * r * w; u32x2 o; o.x = pk2(y[0], y[1]); o.y = pk2(y[2], y[3]); o8[64 * j] = o; }
    }
    const int gt = blockIdx.x * 512 + tid, NT = G * 512;
    float* rope = (float*)(ws + OFF_ROPE);
    for (int e = gt; e < NROPE * 32; e += NT) {
        const int pi = e >> 5, i = e & 31;
        const double pos = pi < 2048 ? (double)pi : (double)(16384 + pi - 2048);
        const double a = pos * ROPE_INV[i];
        const double k = __builtin_rint(a * 0.15915494309189535);
        double r = __builtin_fma(-k, 6.283185307179586, a); r = __builtin_fma(-k, 2.4492935982947064e-16, r);
        double s, c; sincos_pi(r, s, c);
        rope[pi * 64 + i] = (float)c; rope[pi * 64 + 32 + i] = (float)s;
    }
    bf16_t* wsg = (bf16_t*)(ws + OFF_WSG);
    for (int e = gt; e < 8 * 128 * 128 / 2; e += NT) {
        const int idx = 2 * e, j = idx & 127, i = (idx >> 7) & 127;
        const float a = j <= i ? p.sg_w[idx] : 0.f, b = (j + 1) <= i ? p.sg_w[idx + 1] : 0.f;
        ((unsigned*)wsg)[e] = pk2(a, b);
    }
}

constexpr int KROW = 144;
constexpr int KVH_BYTES = 160 * KROW;
constexpr int GROW = 544;
constexpr int L_K = 0, L_V = 2 * KVH_BYTES, L_RED = 4 * KVH_BYTES  , L_RG = L_RED + 32 * 8 * 4;
constexpr int GBUF = 128 * GROW  , L_RED2 = 2 * GBUF  , L_RG2 = L_RED2 + 32 * 8 * 4;

__device__ __forceinline__ s16x4 ldtr(const LAS unsigned char* p) { return __builtin_bit_cast(s16x4, __builtin_amdgcn_ds_read_tr16_b64_v4i16((LAS s16x4*)p)); }

template <int NQB>
__device__ __forceinline__ void attn_core(const LAS unsigned char* Kl, const LAS unsigned char* Vl, const bf16x8 (&qf)[NQB][2], float sink, int kmin,
                                          f32x4 (&o)[NQB][4], int lane) {
    const int fr = lane & 15, fq = lane >> 4, tq = (lane & 15) >> 2, tp = lane & 3;
#pragma unroll
    for (int qb = 0; qb < NQB; ++qb) {
        asm volatile("" ::: "memory");
        const int qi = 16 * qb + fr;
        const bf16x8 q0 = qf[qb][0], q1 = qf[qb][1];
        f32x4 s[10];
#pragma unroll
        for (int t = 0; t < 10; ++t) {
            const LAS unsigned char* kp = Kl + (16 * t + fr) * KROW + 16 * fq;
            const bf16x8 k0 = *(const LAS bf16x8*)kp, k1 = *(const LAS bf16x8*)(kp + 64);
            s[t] = __builtin_amdgcn_mfma_f32_16x16x32_bf16(k0, q0, (f32x4){0.f, 0.f, 0.f, 0.f}, 0, 0, 0);
            s[t] = __builtin_amdgcn_mfma_f32_16x16x32_bf16(k1, q1, s[t], 0, 0, 0);
            if (t & 1) __builtin_amdgcn_sched_barrier(0);
        }
        float mx = -INFINITY;
#pragma unroll
        for (int t = 0; t < 10; ++t)
#pragma unroll
            for (int j = 0; j < 4; ++j) {
                const int kj = 16 * t + 4 * fq + j, diff = 128 + qi - kj;
                const bool valid = (diff >= 0) && (diff < 128) && (kj >= kmin);
                s[t][j] = valid ? s[t][j] : -INFINITY;
                mx = fmaxf(mx, s[t][j]);
            }
        mx = fmaxf(fq_max(mx), sink);
        float sum = 0.f;
#pragma unroll
        for (int t = 0; t < 10; ++t)
#pragma unroll
            for (int j = 0; j < 4; ++j) { const float e = __expf(s[t][j] - mx); s[t][j] = e; sum += e; }
        sum = fq_sum(sum) + __expf(sink - mx);
        const float inv = 1.0f / sum;
#pragma unroll
        for (int dt = 0; dt < 4; ++dt) o[qb][dt] = (f32x4){0.f, 0.f, 0.f, 0.f};
#pragma unroll
        for (int T = 0; T < 5; ++T) {
            u32x4 pw; pw.x = pk2(s[2 * T][0] * inv, s[2 * T][1] * inv); pw.y = pk2(s[2 * T][2] * inv, s[2 * T][3] * inv);
            pw.z = pk2(s[2 * T + 1][0] * inv, s[2 * T + 1][1] * inv); pw.w = pk2(s[2 * T + 1][2] * inv, s[2 * T + 1][3] * inv);
            const bf16x8 pf = __builtin_bit_cast(bf16x8, pw);
            const LAS unsigned char* vp = Vl + (32 * T + 4 * fq + tq) * KROW + 8 * tp;
#pragma unroll
            for (int dt = 0; dt < 4; ++dt) {
                const s16x4 lo = ldtr(vp + 32 * dt), hi = ldtr(vp + 16 * KROW + 32 * dt);
                const bf16x8 vf = __builtin_shufflevector(lo, hi, 0, 1, 2, 3, 4, 5, 6, 7);
                o[qb][dt] = __builtin_amdgcn_mfma_f32_16x16x32_bf16(vf, pf, o[qb][dt], 0, 0, 0);
            }
            __builtin_amdgcn_sched_barrier(0);
        }
    }
}

template <int NQB>
__device__ __forceinline__ void load_q(bf16x8 (&qf)[NQB][2], const bf16_t* Qg  , int nq, int lane) {
    const int fr = lane & 15, fq = lane >> 4;
#pragma unroll
    for (int qb = 0; qb < NQB; ++qb) {
        const int qi = 16 * qb + fr, qic = qi < nq ? qi : nq - 1;
        const bf16_t* qp = Qg + (size_t)qic * AW + 8 * fq;
        qf[qb][0] = *(const bf16x8*)qp; qf[qb][1] = *(const bf16x8*)(qp + 32);
    }
}
__device__ __forceinline__ float rowscale16(const float* ss16) {
    const f32x4* q = (const f32x4*)ss16; const f32x4 t = (q[0] + q[1]) + (q[2] + q[3]);
    return rsqrtf(((t[0] + t[1]) + (t[2] + t[3])) * (1.0f / 1024.0f) + EPS);
}

__device__ __forceinline__ void p2_prompt_att(const Params& p, LAS unsigned char* lds, int unit) {
    const int tid = opaque(threadIdx.x), lane = tid & 63, wave = __builtin_amdgcn_readfirstlane(tid >> 6);
    unsigned char* ws = p.ws;
    const bf16_t* Q = (const bf16_t*)(ws + OFF_Q); const bf16_t* Kb = (const bf16_t*)(ws + OFF_KB); const bf16_t* Vb = (const bf16_t*)(ws + OFF_VB);
    const bf16_t* U = (const bf16_t*)(ws + OFF_U); const bf16_t* Gm = (const bf16_t*)(ws + OFF_G); bf16_t* MIX = (bf16_t*)(ws + OFF_MIX);
    const float* gss = (const float*)(ws + OFF_GSS); const bf16_t* wsg = (const bf16_t*)(ws + OFF_WSG);
    const int b = unit >> 6, s0 = (unit & 63) * 32, row0 = b * 2048 + s0;
    const int fr = lane & 15, fq = lane >> 4, tq = (lane & 15) >> 2, tp = lane & 3;
    LAS float* red = (LAS float*)(lds + L_RED);
    LAS float* rgl = (LAS float*)(lds + L_RG);
    {
        f32x4 o[2][2][4];
        const int kmin = s0 < 128 ? 128 - s0 : 0;
        u32x4 kr[5], vr[5];
#define ATT_LOADKV(ps_) do { _Pragma("unroll") for (int it = 0; it < 5; ++it) { const int c_ = tid + 512 * it, kj_ = c_ >> 4, ch_ = c_ & 15, kp_ = s0 - 128 + kj_; \
            kr[it] = (u32x4){0u, 0u, 0u, 0u}; vr[it] = kr[it]; \
            if (kp_ >= 0) { const size_t g_ = (size_t)(b * 2048 + kp_) * KVW + 128 * (ps_) + ch_ * 8; kr[it] = *(const u32x4*)(Kb + g_); vr[it] = *(const u32x4*)(Vb + g_); } } } while (0)
#define ATT_STOREKV() do { _Pragma("unroll") for (int it = 0; it < 5; ++it) { const int c_ = tid + 512 * it, kj_ = c_ >> 4, ch_ = c_ & 15; \
            const int off_ = ((ch_ >> 3) * 160 + kj_) * KROW + (ch_ & 7) * 16; *(LAS u32x4*)(lds + L_K + off_) = kr[it]; *(LAS u32x4*)(lds + L_V + off_) = vr[it]; } } while (0)
        bf16x8 qf[2][2];
        ATT_LOADKV(0);
        load_q<2>(qf, Q + (size_t)row0 * AW + wave * 64, 32, lane);
        const float sink0 = p.sinks[wave], sink1 = p.sinks[8 + wave];
        ATT_STOREKV();
        __syncthreads();
        ATT_LOADKV(1);
        attn_core<2>(lds + L_K + (wave >> 2) * KVH_BYTES, lds + L_V + (wave >> 2) * KVH_BYTES, qf, sink0, kmin, o[0], lane);
        load_q<2>(qf, Q + (size_t)row0 * AW + (8 + wave) * 64, 32, lane);
        __syncthreads();
        ATT_STOREKV();
        __syncthreads();
        attn_core<2>(lds + L_K + (wave >> 2) * KVH_BYTES, lds + L_V + (wave >> 2) * KVH_BYTES, qf, sink1, kmin, o[1], lane);
#undef ATT_LOADKV
#undef ATT_STOREKV
#pragma unroll
        for (int qb = 0; qb < 2; ++qb) {
            float ss = 0.f;
#pragma unroll
            for (int ps = 0; ps < 2; ++ps)
#pragma unroll
                for (int dt = 0; dt < 4; ++dt) { const f32x4 v = o[ps][qb][dt]; ss += (v[0] * v[0] + v[1] * v[1]) + (v[2] * v[2] + v[3] * v[3]); }
            ss = fq_sum(ss);
            if (fq == 0) red[(16 * qb + fr) * 8 + wave] = ss;
        }
        __syncthreads();
#pragma unroll
        for (int qb = 0; qb < 2; ++qb) {
            const LAS f32x4* rr = (const LAS f32x4*)(red + (16 * qb + fr) * 8); const f32x4 t = rr[0] + rr[1];
            const float ra = rsqrtf(((t[0] + t[1]) + (t[2] + t[3])) * (1.0f / 1024.0f) + EPS);
#pragma unroll
            for (int ps = 0; ps < 2; ++ps)
#pragma unroll
                for (int dt = 0; dt < 4; ++dt) {
                    const f32x4 v = o[ps][qb][dt] * ra; u32x2 w; w.x = pk2(v[0], v[1]); w.y = pk2(v[2], v[3]);
                    *(u32x2*)(MIX + (size_t)(row0 + 16 * qb + fr) * DM + (8 * ps + wave) * 64 + 16 * dt + 4 * fq) = w;
                }
        }
        __syncthreads();
    }
}
__device__ __forceinline__ void p2_prompt_sg(const Params& p, LAS unsigned char* lds, int unit) {
    const int tid = opaque(threadIdx.x), lane = tid & 63, wave = __builtin_amdgcn_readfirstlane(tid >> 6);
    unsigned char* ws = p.ws;
    const bf16_t* U = (const bf16_t*)(ws + OFF_U); const bf16_t* Gm = (const bf16_t*)(ws + OFF_G); bf16_t* MIX = (bf16_t*)(ws + OFF_MIX);
    const float* gss = (const float*)(ws + OFF_GSS); const bf16_t* wsg = (const bf16_t*)(ws + OFF_WSG);
    const int b = unit >> 6, s0 = (unit & 63) * 32, row0 = b * 2048 + s0;
    const int fr = lane & 15, fq = lane >> 4, tq = (lane & 15) >> 2, tp = lane & 3;
    LAS float* red = (LAS float*)(lds + L_RED2);
    LAS float* rgl = (LAS float*)(lds + L_RG2);
    {
        const int c = (s0 >> 5) & 3, crow0 = b * 2048 + (s0 & ~127), nrows = 32 * (c + 1), nk = 2 * (c + 1);
        const int sj = tid >> 5, sch = tid & 31;
        u32x4 gv[8]; f32x4 gn0, gn1;
#define SG_LOADG(ps_) do { _Pragma("unroll") for (int k = 0; k < 8; ++k) if (k < nk) gv[k] = *(const u32x4*)(Gm + (size_t)(crow0 + sj + 16 * k) * SGW + 256 * (ps_) + 8 * sch); \
            gn0 = *(const f32x4*)(p.sg_norm + 256 * (ps_) + 8 * sch); gn1 = *(const f32x4*)(p.sg_norm + 256 * (ps_) + 8 * sch + 4); } while (0)
#define SG_STOREG(buf_) do { _Pragma("unroll") for (int k = 0; k < 8; ++k) if (k < nk) { const float r_ = rgl[sj + 16 * k]; const f32x4 n0_ = gn0 * r_, n1_ = gn1 * r_; const u32x4 g_ = gv[k]; u32x4 w_; \
            w_.x = pk2(bf_lo(g_.x) * n0_[0], bf_hi(g_.x) * n0_[1]); w_.y = pk2(bf_lo(g_.y) * n0_[2], bf_hi(g_.y) * n0_[3]); \
            w_.z = pk2(bf_lo(g_.z) * n1_[0], bf_hi(g_.z) * n1_[1]); w_.w = pk2(bf_lo(g_.w) * n1_[2], bf_hi(g_.w) * n1_[3]); \
            *(LAS u32x4*)(lds + (buf_) * GBUF + (sj + 16 * k) * GROW + sch * 16) = w_; } } while (0)
        SG_LOADG(0);
        if (tid < nrows) rgl[tid] = rowscale16(gss + (size_t)(crow0 + tid) * 16);
        __syncthreads();
        SG_STOREG(0);
        __syncthreads();
        f32x4 sg[4][2][2];
#pragma unroll
        for (int ps = 0; ps < 4; ++ps) {
            const int hl = wave >> 2, head = 2 * ps + hl, dq = wave & 3;
            if (ps < 3) SG_LOADG(ps + 1);
            bf16x8 wf[4][2]; u32x2 uv[2][2]; float bias[2];
#pragma unroll
            for (int J = 0; J < 4; ++J)
                if (J <= c) {
#pragma unroll
                    for (int ib = 0; ib < 2; ++ib) wf[J][ib] = *(const bf16x8*)(wsg + ((size_t)(head * 128 + 32 * c + 16 * ib + fr) * 128 + 32 * J + 8 * fq));
                }
#pragma unroll
            for (int ib = 0; ib < 2; ++ib) {
                bias[ib] = p.sg_b[head * 128 + 32 * c + 16 * ib + fr];
#pragma unroll
                for (int dt = 0; dt < 2; ++dt) uv[ib][dt] = *(const u32x2*)(U + (size_t)(row0 + 16 * ib + fr) * SGW + head * 128 + 32 * dq + 16 * dt + 4 * fq);
            }
            f32x4 a[2][2];
#pragma unroll
            for (int ib = 0; ib < 2; ++ib)
#pragma unroll
                for (int dt = 0; dt < 2; ++dt) a[ib][dt] = (f32x4){0.f, 0.f, 0.f, 0.f};
#pragma unroll
            for (int J = 0; J < 4; ++J)
                if (J <= c) {
                    const LAS unsigned char* gp = lds + (ps & 1) * GBUF + (32 * J + 8 * fq + tq) * GROW + (128 * hl + 32 * dq + 4 * tp) * 2;
#pragma unroll
                    for (int dt = 0; dt < 2; ++dt) {
                        const s16x4 lo = ldtr(gp + 32 * dt), hi = ldtr(gp + 4 * GROW + 32 * dt);
                        const bf16x8 gf = __builtin_shufflevector(lo, hi, 0, 1, 2, 3, 4, 5, 6, 7);
#pragma unroll
                        for (int ib = 0; ib < 2; ++ib) a[ib][dt] = __builtin_amdgcn_mfma_f32_16x16x32_bf16(gf, wf[J][ib], a[ib][dt], 0, 0, 0);
                    }
                }
#pragma unroll
            for (int ib = 0; ib < 2; ++ib)
#pragma unroll
                for (int dt = 0; dt < 2; ++dt) {
                    f32x4 v = a[ib][dt] + bias[ib];
                    v[0] *= bf_lo(uv[ib][dt].x); v[1] *= bf_hi(uv[ib][dt].x); v[2] *= bf_lo(uv[ib][dt].y); v[3] *= bf_hi(uv[ib][dt].y);
                    sg[ps][ib][dt] = v;
                }
            if (ps < 3) SG_STOREG((ps + 1) & 1);
            __syncthreads();
        }
#undef SG_LOADG
#undef SG_STOREG
#pragma unroll
        for (int ib = 0; ib < 2; ++ib) {
            float ss = 0.f;
#pragma unroll
            for (int ps = 0; ps < 4; ++ps)
#pragma unroll
                for (int dt = 0; dt < 2; ++dt) { const f32x4 v = sg[ps][ib][dt]; ss += (v[0] * v[0] + v[1] * v[1]) + (v[2] * v[2] + v[3] * v[3]); }
            ss = fq_sum(ss);
            if (fq == 0) red[(16 * ib + fr) * 8 + wave] = ss;
        }
        __syncthreads();
#pragma unroll
        for (int ib = 0; ib < 2; ++ib) {
            const LAS f32x4* rr = (const LAS f32x4*)(red + (16 * ib + fr) * 8); const f32x4 t = rr[0] + rr[1];
            const float rs = rsqrtf(((t[0] + t[1]) + (t[2] + t[3])) * (1.0f / 1024.0f) + EPS);
#pragma unroll
            for (int ps = 0; ps < 4; ++ps)
#pragma unroll
                for (int dt = 0; dt < 2; ++dt) {
                    const f32x4 v = sg[ps][ib][dt] * rs; u32x2 w; w.x = pk2(v[0], v[1]); w.y = pk2(v[2], v[3]);
                    *(u32x2*)(MIX + (size_t)(row0 + 16 * ib + fr) * DM + AW + (2 * ps + (wave >> 2)) * 128 + 32 * (wave & 3) + 16 * dt + 4 * fq) = w;
                }
        }
        __syncthreads();
    }
}

__device__ __forceinline__ void p2_sample_unit(const Params& p, LAS unsigned char* lds, int b) {
    const int tid = opaque(threadIdx.x), lane = tid & 63, wave = __builtin_amdgcn_readfirstlane(tid >> 6);
    unsigned char* ws = p.ws;
    const bf16_t* Q = (const bf16_t*)(ws + OFF_Q); const bf16_t* Kb = (const bf16_t*)(ws + OFF_KB); const bf16_t* Vb = (const bf16_t*)(ws + OFF_VB);
    const bf16_t* U = (const bf16_t*)(ws + OFF_U); const bf16_t* Gm = (const bf16_t*)(ws + OFF_G); bf16_t* MIX = (bf16_t*)(ws + OFF_MIX);
    const float* gss = (const float*)(ws + OFF_GSS);
    const int row0 = MP + 8 * b, fr = lane & 15, fq = lane >> 4;
    LAS float* red = (LAS float*)(lds + L_RED);
    LAS float* rgl = (LAS float*)(lds + L_RG);
    {
        f32x4 o[2][1][4];
#pragma unroll
        for (int ps = 0; ps < 2; ++ps) {
            bf16x8 qf1[1][2];
            load_q<1>(qf1, Q + (size_t)row0 * AW + (8 * ps + wave) * 64, 8, lane);
            const float sinkv = p.sinks[8 * ps + wave];
            {
                const int kr = tid >> 4, ch = tid & 15;
                f32x4 ck[4][2], cv[4][2]; u32x4 nk = (u32x4){0u, 0u, 0u, 0u}, nv = nk;
#pragma unroll
                for (int it = 0; it < 4; ++it) {
                    const size_t g = ((size_t)(b * 128 + kr + 32 * it)) * KVW + 128 * ps + ch * 8;
                    ck[it][0] = *(const f32x4*)(p.cache_k + g); ck[it][1] = *(const f32x4*)(p.cache_k + g + 4); cv[it][0] = *(const f32x4*)(p.cache_v + g); cv[it][1] = *(const f32x4*)(p.cache_v + g + 4);
                }
                if (kr < 8) { const size_t g = (size_t)(row0 + kr) * KVW + 128 * ps + ch * 8; nk = *(const u32x4*)(Kb + g); nv = *(const u32x4*)(Vb + g); }
#pragma unroll
                for (int it = 0; it < 4; ++it) {
                    const int kj = kr + 32 * it;
                    const f32x4 k0 = ck[it][0], k1 = ck[it][1], v0 = cv[it][0], v1 = cv[it][1];
                    u32x4 kv, vv;
                    kv.x = pk2(k0[0], k0[1]); kv.y = pk2(k0[2], k0[3]); kv.z = pk2(k1[0], k1[1]); kv.w = pk2(k1[2], k1[3]);
                    vv.x = pk2(v0[0], v0[1]); vv.y = pk2(v0[2], v0[3]); vv.z = pk2(v1[0], v1[1]); vv.w = pk2(v1[2], v1[3]);
                    if (kj >= 8) {
                        const size_t d = ((size_t)(b * 128 + kj - 8)) * KVW + 128 * ps + ch * 8;
                        float* kd = p.out + OUT_KWS + d; float* vd = p.out + OUT_VWS + d;
                        *(f32x4*)kd = k0; *(f32x4*)(kd + 4) = k1; *(f32x4*)vd = v0; *(f32x4*)(vd + 4) = v1;
                    }
                    const int off = ((ch >> 3) * 160 + kj) * KROW + (ch & 7) * 16;
                    *(LAS u32x4*)(lds + L_K + off) = kv; *(LAS u32x4*)(lds + L_V + off) = vv;
                }
                const int off4 = ((ch >> 3) * 160 + 128 + kr) * KROW + (ch & 7) * 16;
                *(LAS u32x4*)(lds + L_K + off4) = nk; *(LAS u32x4*)(lds + L_V + off4) = nv;
            }
            __syncthreads();
            const int head = 8 * ps + wave, kvl = wave >> 2;
            attn_core<1>(lds + L_K + kvl * KVH_BYTES, lds + L_V + kvl * KVH_BYTES, qf1, sinkv, 0, o[ps], lane);
            __syncthreads();
        }
        float ss = 0.f;
#pragma unroll
        for (int ps = 0; ps < 2; ++ps)
#pragma unroll
            for (int dt = 0; dt < 4; ++dt) { const f32x4 v = o[ps][0][dt]; ss += (v[0] * v[0] + v[1] * v[1]) + (v[2] * v[2] + v[3] * v[3]); }
        ss = fq_sum(ss);
        if (fq == 0) red[fr * 8 + wave] = ss;
        __syncthreads();
        {
            const LAS f32x4* rr = (const LAS f32x4*)(red + fr * 8); const f32x4 t = rr[0] + rr[1];
            const float ra = rsqrtf(((t[0] + t[1]) + (t[2] + t[3])) * (1.0f / 1024.0f) + EPS);
            if (fr < 8) {
#pragma unroll
                for (int ps = 0; ps < 2; ++ps)
#pragma unroll
                    for (int dt = 0; dt < 4; ++dt) {
                        const f32x4 v = o[ps][0][dt] * ra; u32x2 w; w.x = pk2(v[0], v[1]); w.y = pk2(v[2], v[3]);
                        *(u32x2*)(MIX + (size_t)(row0 + fr) * DM + (8 * ps + wave) * 64 + 16 * dt + 4 * fq) = w;
                    }
            }
        }
        __syncthreads();
    }
}
__device__ __forceinline__ void p2_sample_sg(const Params& p, LAS unsigned char* lds, int b) {
    const int tid = opaque(threadIdx.x), lane = tid & 63, wave = __builtin_amdgcn_readfirstlane(tid >> 6);
    unsigned char* ws = p.ws;
    const bf16_t* U = (const bf16_t*)(ws + OFF_U); const bf16_t* Gm = (const bf16_t*)(ws + OFF_G); bf16_t* MIX = (bf16_t*)(ws + OFF_MIX);
    const float* gss = (const float*)(ws + OFF_GSS);
    const int row0 = MP + 8 * b;
    LAS float* red = (LAS float*)(lds + L_RED);
    LAS float* rgl = (LAS float*)(lds + L_RG);
    {
        if (tid < 8) rgl[tid] = rowscale16(gss + (size_t)(row0 + tid) * 16);
        __syncthreads();
        const int col = 2 * tid, h = col >> 7;
        const float n0 = p.sg_norm[col], n1 = p.sg_norm[col + 1];
        float g0[8], g1[8];
#pragma unroll
        for (int j = 0; j < 8; ++j) {
            const unsigned gv = *(const unsigned*)(Gm + (size_t)(row0 + j) * SGW + col); const float r = rgl[j];
            g0[j] = bf_lo(gv) * r * n0; g1[j] = bf_hi(gv) * r * n1;
            float* sv = p.out + OUT_SGV + (size_t)(b * 8 + j) * SGW + col; sv[0] = g0[j]; sv[1] = g1[j];
        }
        float o0[8], o1[8];
#pragma unroll
        for (int i = 0; i < 8; ++i) {
            float m0 = p.sg_b[h * 128 + i], m1 = m0;
#pragma unroll
            for (int j = 0; j <= i; ++j) { const float w = p.sg_w[(size_t)(h * 128 + i) * 128 + j]; m0 += w * g0[j]; m1 += w * g1[j]; }
            const unsigned uv = *(const unsigned*)(U + (size_t)(row0 + i) * SGW + col);
            o0[i] = m0 * bf_lo(uv); o1[i] = m1 * bf_hi(uv);
            const float ss = wave_sum(o0[i] * o0[i] + o1[i] * o1[i]);
            if (lane == 0) red[i * 8 + wave] = ss;
        }
        __syncthreads();
#pragma unroll
        for (int i = 0; i < 8; ++i) {
            const LAS f32x4* rr = (const LAS f32x4*)(red + i * 8); const f32x4 t = rr[0] + rr[1];
            const float rs = rsqrtf(((t[0] + t[1]) + (t[2] + t[3])) * (1.0f / 1024.0f) + EPS);
            *(unsigned*)(MIX + (size_t)(row0 + i) * DM + AW + col) = pk2(o0[i] * rs, o1[i] * rs);
        }
        __syncthreads();
    }
}


typedef unsigned gu32;
#define XB_TMO      128
#define XB_XCNT(j)  (256  + 64 * (j))
#define XB_XSUB(j)  (1280 + 64 * (j))
#define XB_XGEN(j)  (2304 + 64 * (j))
#define XB_TOP      3328
#define XB_TOPGEN   3392
#define XCD_BAR_WORDS 3456
#define XB_SPIN_CAP (1u << 18)
__device__ __forceinline__ unsigned xb_ld(unsigned* p)              { return __hip_atomic_load(p, __ATOMIC_RELAXED, __HIP_MEMORY_SCOPE_AGENT); }
__device__ __forceinline__ unsigned xb_add(unsigned* p, unsigned v) { return __hip_atomic_fetch_add(p, v, __ATOMIC_RELAXED, __HIP_MEMORY_SCOPE_AGENT); }
__device__ __forceinline__ unsigned xb_xcc_id() { return (unsigned)__builtin_amdgcn_s_getreg((3 << 11) | 20) & 0xFu; }
#define XB_SPIN(cond, bar) do { unsigned _sp = 0; while (cond) { __builtin_amdgcn_s_sleep(1); \
    if ((++_sp & 255u) == 0u) { if (xb_ld(&(bar)[XB_TMO])) break; if (_sp > XB_SPIN_CAP) { atomicAdd(&(bar)[XB_TMO], 1u); break; } } } } while (0)
struct XcdBarrier { unsigned* bar; unsigned x; volatile LAS unsigned* st; };
__device__ __forceinline__ XcdBarrier xcd_barrier_post(unsigned* bar, volatile LAS unsigned* st) {
    XcdBarrier b; b.bar = bar; b.x = xb_xcc_id(); b.st = st;
    if (threadIdx.x == 0) (void)xb_add(&bar[XB_XCNT(b.x)], 1u);
    return b;
}
__device__ __forceinline__ void xcd_barrier_complete(unsigned* bar, unsigned x, unsigned& nloc, unsigned& nx) {
    const unsigned G = gridDim.x * gridDim.y * gridDim.z;
    unsigned sum, cnt, mine, sp = 0u;
    for (;;) {
        sum = 0u; cnt = 0u; mine = 0u;
#pragma unroll
        for (unsigned j = 0; j < 16; ++j) { const unsigned c = xb_ld(&bar[XB_XCNT(j)]); sum += c; cnt += (c > 0u) ? 1u : 0u; mine = (j == x) ? c : mine; }
        if (sum == G) break;
        __builtin_amdgcn_s_sleep(1);
        if ((++sp & 255u) == 0u) { if (xb_ld(&bar[XB_TMO])) break; if (sp > XB_SPIN_CAP) { atomicAdd(&bar[XB_TMO], 1u); break; } }
    }
    nloc = mine > 0u ? mine : 1u; nx = cnt > 0u ? cnt : 1u;
}
__device__ __forceinline__ void xcd_barrier(const XcdBarrier& b) {
    asm volatile("s_waitcnt vmcnt(0)" ::: "memory");
    __syncthreads();
    if (threadIdx.x == 0) {
        unsigned* bar = b.bar;
        __builtin_amdgcn_s_waitcnt(0);
        unsigned nloc = b.st[0], nx = b.st[1];
        if (nloc == 0u) { xcd_barrier_complete(bar, b.x, nloc, nx); b.st[0] = nloc; b.st[1] = nx; }
        const unsigned old = xb_add(&bar[XB_XSUB(b.x)], 1u);
        const unsigned gen = old / nloc;
        if (old + 1u == (gen + 1u) * nloc) {
            __builtin_amdgcn_fence(__ATOMIC_RELEASE, "agent");
            asm volatile("s_waitcnt vmcnt(0)" ::: "memory");
            const unsigned og = xb_add(&bar[XB_TOP], 1u);
            const unsigned tg = og / nx;
            if (og + 1u == (tg + 1u) * nx) xb_add(&bar[XB_TOPGEN], 1u);
            else XB_SPIN(xb_ld(&bar[XB_TOPGEN]) == tg, bar);
            __builtin_amdgcn_fence(__ATOMIC_ACQUIRE, "agent");
            xb_add(&bar[XB_XGEN(b.x)], 1u);
            asm volatile("s_waitcnt vmcnt(0)" ::: "memory");
        } else {
            XB_SPIN(xb_ld(&bar[XB_XGEN(b.x)]) == gen, bar);
            __builtin_amdgcn_fence(__ATOMIC_ACQUIRE, "agent");
            asm volatile("s_waitcnt vmcnt(0)" ::: "memory");
        }
    }
    __syncthreads();
}

#ifndef P3_MAXSF
#define P3_MAXSF 4
#endif
#ifndef P4_MAXSF
#define P4_MAXSF 4
#endif
#ifndef REP_P0
#define REP_P0 0
#endif
#ifndef REP_P2
#define REP_P2 0
#endif
#ifndef REP_P1
#define REP_P1 0
#endif
#ifndef REP_P3
#define REP_P3 0
#endif
#ifndef REP_P4
#define REP_P4 0
#endif
#ifndef EXTRA_SYNCS
#define EXTRA_SYNCS 0
#endif
#ifndef USE_CG_SYNC
#define USE_CG_SYNC 0
#endif
constexpr int LDS_BYTES = 147456;
__global__ void __launch_bounds__(512, 2) hymba_fwd(Params p) {
    extern __shared__ __attribute__((aligned(16))) unsigned char lds_raw[];
    LAS unsigned char* lds = (LAS unsigned char*)lds_raw;
    cg::grid_group grid = cg::this_grid();
    const int G = gridDim.x;
    unsigned char* ws = p.ws;
    volatile LAS unsigned* bst = (volatile LAS unsigned*)(lds + 147200);
    if (threadIdx.x < 2) bst[threadIdx.x] = 0u;
    __syncthreads();
    const XcdBarrier xbar = xcd_barrier_post((unsigned*)(ws + OFF_BAR), bst);
    if (p.out == nullptr) grid.sync();
#if USE_CG_SYNC
#define SEAM() grid.sync()
#else
#define SEAM() xcd_barrier(xbar)
#endif

#pragma unroll 1
    for (int rep = 0; rep <= REP_P0; ++rep) {
    p0_prologue(p, lds);
    SEAM();
    }
#pragma unroll 1
    for (int rep = 0; rep < EXTRA_SYNCS; ++rep) SEAM();
#pragma unroll 1
    for (int rep1 = 0; rep1 <= REP_P1; ++rep1) {
        pg8::Gemm g{(const bf16_t*)(ws + OFF_XN), (const bf16_t*)(ws + OFF_WIN), MT, INW, DM}; pg8::TailSplitOrder S; S.init(MT, INW, DM, G, (int)blockIdx.x);
        EpiProj E{(bf16_t*)(ws + OFF_Q), (bf16_t*)(ws + OFF_KB), (bf16_t*)(ws + OFF_VB), (bf16_t*)(ws + OFF_U), (bf16_t*)(ws + OFF_G), (float*)(ws + OFF_GSS),
                  (const float*)(ws + OFF_ROPE), p.q_norm, p.k_norm, p.out};
        const pg8::SplitCtx sc{(float*)(ws + OFF_WO), 1 << 30, nullptr, (unsigned*)(ws + OFF_BAR + 16384)};
        pg8::gemm_phase(lds, g, S, E, sc);
    SEAM();
    }
#pragma unroll 1
    for (int rep = 0; rep <= REP_P2; ++rep) {
        for (int u = blockIdx.x; u < 256; u += G) { p2_prompt_att(p, lds, u); p2_prompt_sg(p, lds, u); }
        for (int i = blockIdx.x; i < 256; i += G) { if (i < 128) p2_sample_unit(p, lds, i); else p2_sample_sg(p, lds, i - 128); }
        SEAM();
    }
#pragma unroll 1
    for (int rep3 = 0; rep3 <= REP_P3; ++rep3) {
        pg8::Gemm g{(const bf16_t*)(ws + OFF_MIX), (const bf16_t*)(ws + OFF_WO), MT, DM, DM}; pg8::TailSplitOrder S; S.init(MT, DM, DM, G, (int)blockIdx.x, P3_MAXSF);
        EpiWo E{p, (bf16_t*)(ws + OFF_HB), (float*)(ws + OFF_HSS)};
        const pg8::SplitCtx sc{(float*)(ws + OFF_XN), 1 << 30, nullptr, (unsigned*)(ws + OFF_BAR + 16384) + 1024};
        pg8::gemm_phase(lds, g, S, E, sc);
    SEAM();
    }
#pragma unroll 1
    for (int rep4 = 0; rep4 <= REP_P4; ++rep4) {
        pg8::Gemm g{(const bf16_t*)(ws + OFF_HB), (const bf16_t*)(ws + OFF_WGU), MT, 2 * FF, DM}; pg8::TailSplitOrder S; S.init(MT, 2 * FF, DM, G, (int)blockIdx.x, P4_MAXSF);
        EpiGU E{(const float*)(ws + OFF_HSS), (bf16_t*)(ws + OFF_ACT)};
        const pg8::SplitCtx sc{(float*)(ws + OFF_WIN), (int)((OFF_WGU - OFF_WIN) / 262144), (float*)(ws + OFF_MIX), (unsigned*)(ws + OFF_BAR + 16384) + 2048};
        pg8::gemm_phase(lds, g, S, E, sc);
    SEAM();
    }
    {
        pg8::Gemm g{(const bf16_t*)(ws + OFF_ACT), (const bf16_t*)(ws + OFF_WDN), MT, DM, FF}; pg8::TailSplitOrder S; S.init(MT, DM, FF, G, (int)blockIdx.x);
        EpiDown E{p.out, (const bf16_t*)(ws + OFF_HB)};
        const pg8::SplitCtx sc{(float*)(ws + OFF_WIN), 1 << 30, nullptr, (unsigned*)(ws + OFF_BAR + 16384) + 3072};
        pg8::gemm_phase(lds, g, S, E, sc);
    }
}

extern "C" void kernel_launch(void* const* d_in, const int* in_sizes, int n_in, void* d_out, int out_size, void* d_ws, size_t ws_size, hipStream_t stream) {
    static int grid = 0;
    if (grid == 0) {
        if (n_in != 19 || ws_size < WS_END) { fprintf(stderr, "kernel_launch: need 19 inputs and >= %zu bytes of workspace (got %d, %zu)\n", (size_t)WS_END, n_in, ws_size); grid = -1; return; }
        int dev = 0, cus = 0, per_cu = 0;
        hipGetDevice(&dev);
        hipDeviceGetAttribute(&cus, hipDeviceAttributeMultiprocessorCount, dev);
        if (hipFuncSetAttribute((const void*)hymba_fwd, hipFuncAttributeMaxDynamicSharedMemorySize, LDS_BYTES) != hipSuccess) { fprintf(stderr, "kernel_launch: hipFuncSetAttribute failed\n"); grid = -1; return; }
        if (hipOccupancyMaxActiveBlocksPerMultiprocessor(&per_cu, (const void*)hymba_fwd, 512, LDS_BYTES) != hipSuccess || per_cu < 1) { fprintf(stderr, "kernel_launch: occupancy query failed (%d)\n", per_cu); per_cu = 1; }
        (void)hipGetLastError();
        grid = cus * (per_cu > 1 ? 1 : per_cu);
    }
    if (grid < 0) return;
    if (hipMemsetAsync((char*)d_ws + OFF_BAR, 0, BAR_BYTES, stream) != hipSuccess) { fprintf(stderr, "kernel_launch: memset failed\n"); return; }
    Params p{};
    const float** f = (const float**)&p;
    for (int i = 0; i < 19; ++i) f[i] = (const float*)d_in[i];
    p.out = (float*)d_out; p.ws = (unsigned char*)d_ws;
    void* args[] = {&p};
    hipError_t e = hipLaunchCooperativeKernel((const void*)hymba_fwd, dim3(grid), dim3(512), args, LDS_BYTES, stream);
    if (e != hipSuccess) fprintf(stderr, "cooperative launch failed: %s (grid %d)\n", hipGetErrorString(e), grid);
}
```

```cpp
#include <hip/hip_runtime.h>
#include <hip/hip_cooperative_groups.h>
#include <cstdio>
#include <cstdint>
namespace cg = cooperative_groups;

#define LAS __attribute__((address_space(3)))
typedef unsigned short bf16_t;
typedef short bf16x8 __attribute__((ext_vector_type(8)));
typedef short s16x4 __attribute__((ext_vector_type(4)));
typedef float f32x4 __attribute__((ext_vector_type(4)));
typedef unsigned u32x4 __attribute__((ext_vector_type(4)));
typedef unsigned u32x2 __attribute__((ext_vector_type(2)));

constexpr int DM = 2048, MP = 8192, MS = 1024, MT = MP + MS;
constexpr int INW = 3584, FF = 5632, AW = 1024, SGW = 1024, KVW = 256;
constexpr float EPS = 1e-6f;
constexpr int NROPE = 2056;

constexpr size_t OFF_WIN = 0;
constexpr size_t OFF_WO = OFF_WIN + (size_t)INW * DM * 2;
constexpr size_t OFF_WGU = OFF_WO + (size_t)DM * DM * 2;
constexpr size_t OFF_WDN = OFF_WGU + (size_t)2 * FF * DM * 2;
constexpr size_t OFF_HB = OFF_WDN + (size_t)DM * FF * 2;
constexpr size_t OFF_ROPE = OFF_HB + (size_t)MT * DM * 2;
constexpr size_t OFF_WSG = OFF_ROPE + (size_t)NROPE * 64 * 4;
constexpr size_t OFF_GSS = OFF_WSG + (size_t)8 * 128 * 128 * 2;
constexpr size_t OFF_HSS = OFF_GSS + (size_t)MT * 16 * 4;
constexpr size_t OFF_BAR = OFF_HSS + (size_t)MT * 32 * 4;
constexpr size_t BAR_BYTES = 32768;
constexpr size_t OFF_ACT = OFF_BAR + BAR_BYTES;
constexpr size_t OFF_XN = OFF_ACT;
constexpr size_t OFF_Q = OFF_XN + (size_t)MT * DM * 2;
constexpr size_t OFF_KB = OFF_Q + (size_t)MT * AW * 2;
constexpr size_t OFF_VB = OFF_KB + (size_t)MT * KVW * 2;
constexpr size_t OFF_U = OFF_VB + (size_t)MT * KVW * 2;
constexpr size_t OFF_G = OFF_U + (size_t)MT * SGW * 2;
constexpr size_t OFF_MIX = OFF_G + (size_t)MT * SGW * 2;
constexpr size_t WS_END = OFF_MIX + (size_t)152 * 262144;
static_assert(OFF_ACT + (size_t)MT * FF * 2 <= OFF_MIX, "ACT overlay fits");
static_assert((size_t)256 * 262144 <= OFF_WDN && (size_t)256 * 262144 <= OFF_MIX - OFF_XN, "partial-tile slots overlay only dead buffers");
static_assert(OFF_ACT % 256 == 0 && OFF_ROPE % 256 == 0 && OFF_WSG % 256 == 0, "alignment");

constexpr size_t OUT_Y = 0;
constexpr size_t OUT_KWP = (size_t)MT * DM;
constexpr size_t OUT_VWP = OUT_KWP + 4 * 128 * 256;
constexpr size_t OUT_KWS = OUT_VWP + 4 * 128 * 256;
constexpr size_t OUT_VWS = OUT_KWS + (size_t)128 * 128 * 256;
constexpr size_t OUT_SGV = OUT_VWS + (size_t)128 * 128 * 256;

struct Params {
    const float *x_prompt, *x_sample, *cache_k, *cache_v, *attn_norm, *w_in, *q_norm, *k_norm, *sinks, *sg_norm, *sg_w, *sg_b,
        *attn_out_norm, *sg_out_norm, *w_o, *ffn_norm, *w_gate, *w_up, *w_down;
    float* out; unsigned char* ws;
};

__device__ const double ROPE_INV[32] = {1.0, 0.7498942093324559, 0.5623413251903491, 0.4216965034285822, 0.31622776601683794, 0.23713737056616552, 0.1778279410038923, 0.1333521432163324, 0.1, 0.07498942093324558, 0.05623413251903491, 0.042169650342858224, 0.03162277660168379, 0.023713737056616554, 0.01778279410038923, 0.01333521432163324, 0.01, 0.007498942093324558, 0.005623413251903491, 0.004216965034285823, 0.0031622776601683794, 0.0023713737056616554, 0.0017782794100389228, 0.001333521432163324, 0.001, 0.0007498942093324559, 0.0005623413251903491, 0.00042169650342858224, 0.00031622776601683794, 0.00023713737056616554, 0.00017782794100389227, 0.0001333521432163324};

__device__ __forceinline__ unsigned pk2(float lo, float hi) { unsigned r; asm volatile("v_cvt_pk_bf16_f32 %0, %1, %2" : "=v"(r) : "v"(lo), "v"(hi)); return r; }
__device__ __forceinline__ int opaque(int x) { asm volatile("" : "+v"(x)); return x; }
__device__ __forceinline__ float bf_lo(unsigned w) { return __builtin_bit_cast(float, w << 16); }
__device__ __forceinline__ float bf_hi(unsigned w) { return __builtin_bit_cast(float, w & 0xffff0000u); }
__device__ __forceinline__ float gelu_tanh(float x) {
    const float y = 1.5957691216057308f * (x + 0.044715f * x * x * x);
    return x * __builtin_amdgcn_rcpf(1.0f + __expf(-y));
}
typedef float f32x2 __attribute__((ext_vector_type(2)));
__device__ __forceinline__ f32x2 gelu2(f32x2 x) {
    const f32x2 t = ((x * x) * 0.044715f + 1.0f) * x;
    const f32x2 z = t * (-1.5957691216057308f * 1.4426950408889634f);
    f32x2 e; e.x = __builtin_amdgcn_exp2f(z.x); e.y = __builtin_amdgcn_exp2f(z.y);
    const f32x2 d = e + 1.0f;
    f32x2 r; r.x = __builtin_amdgcn_rcpf(d.x); r.y = __builtin_amdgcn_rcpf(d.y);
    return x * r;
}
__device__ __forceinline__ f32x2 silu_mul2(f32x2 g, f32x2 u) {
    const f32x2 z = g * (-1.4426950408889634f);
    f32x2 e; e.x = __builtin_amdgcn_exp2f(z.x); e.y = __builtin_amdgcn_exp2f(z.y);
    const f32x2 d = e + 1.0f;
    f32x2 r; r.x = __builtin_amdgcn_rcpf(d.x); r.y = __builtin_amdgcn_rcpf(d.y);
    return (g * r) * u;
}
__device__ __forceinline__ float silu(float x) { return x * __builtin_amdgcn_rcpf(1.0f + __expf(-x)); }
__device__ __forceinline__ float wave_sum(float v) {
#pragma unroll
    for (int o = 1; o < 64; o <<= 1) v += __shfl_xor(v, o);
    return v;
}
__device__ __forceinline__ float fq_sum(float v) { v += __shfl_xor(v, 16); v += __shfl_xor(v, 32); return v; }
__device__ __forceinline__ float fq_max(float v) { v = fmaxf(v, __shfl_xor(v, 16)); v = fmaxf(v, __shfl_xor(v, 32)); return v; }
__device__ __forceinline__ const float* xrow(const Params& p, int row) { return row < MP ? p.x_prompt + (size_t)row * DM : p.x_sample + (size_t)(row - MP) * DM; }

namespace pg8 {
constexpr int BM = 256, BK = 64, HALF = 128, HTB = HALF * BK * 2, STAGE_BYTES = 8 * HTB, NXCD = 8, WGM = 8;
__host__ __device__ __forceinline__ int lds_byte(int r, int c) { const int st = (r >> 4) * 2 + (c >> 5), rr = r & 15, cc = c & 31, ob = rr * 64 + cc * 2; return st * 1024 + (ob ^ (((ob >> 9) & 1) << 5)); }
__host__ __device__ __forceinline__ void stage_rc(int b, int& R, int& C) { const int st = b / 1024, sb = b % 1024, swz = sb ^ (((sb >> 9) & 1) << 5); R = (st >> 1) * 16 + swz / 64; C = (st & 1) * 32 + (swz % 64) / 2; }
struct Unit { int pm, pn, kt0, nkt, sq, sj, sf; };
struct Gemm { const bf16_t* A; const bf16_t* Bt; int M, N, K; };
struct TailSplitOrder {
    int nM, nN, nwg, G, c, ntk, nfull, rem, sf;
    __device__ void init(int M, int N, int K, int G_, int c_, int maxsf = 8) {
        nM = M / BM; nN = N / BM; nwg = nM * nN; G = G_; c = c_; ntk = K / BK; nfull = nwg / G; rem = nwg % G;
        sf = rem ? G / rem : 1; if (sf > ntk / 2) sf = ntk / 2; if (sf > maxsf) sf = maxsf; if (sf < 2) sf = 1;
    }
    __device__ void tile(int L, Unit& u) const {
        int wgid = L; { const int q = nwg / NXCD, r = nwg % NXCD, xcd = wgid % NXCD, off = wgid / NXCD; wgid = (xcd < r ? xcd * (q + 1) : r * (q + 1) + (xcd - r) * q) + off; }
        const int nig = WGM * nN, gid = wgid / nig, fm = gid * WGM, gsz = (nM - fm) < WGM ? (nM - fm) : WGM;
        u.pm = fm + ((wgid % nig) % gsz); u.pn = (wgid % nig) / gsz;
    }
    __device__ bool next(int i, Unit& u) const {
        u.kt0 = 0; u.nkt = ntk; u.sq = 0; u.sj = 0; u.sf = 1;
        if (i < nfull) { tile(i * G + c, u); return true; }
        if (i > nfull || rem == 0) return false;
        if (sf == 1) { if (c >= rem) return false; tile(nfull * G + c, u); return true; }
        const int q = c / sf, j = c % sf; if (q >= rem) return false;
        tile(nfull * G + q, u);
        const int pp = ntk / 2, a = pp * j / sf, b = pp * (j + 1) / sf;
        u.kt0 = 2 * a; u.nkt = 2 * (b - a); u.sq = q; u.sj = j; u.sf = sf; return true;
    }
};
struct SplitCtx { float* part0; int n0; float* part1; unsigned* ctr; };
template <class Epi, class Sched>
__device__ __forceinline__ void gemm_phase(LAS unsigned char* lds, const Gemm g, const Sched& S, const Epi& E, const SplitCtx sc) {
    const int tid = opaque(threadIdx.x), wid = __builtin_amdgcn_readfirstlane(tid >> 6), lane = tid & 63, wr = wid >> 2, wc = wid & 3, fr = lane & 15, fq = lane >> 4;
    const int K = g.K;
    unsigned voffA[2];
#pragma unroll
    for (int i = 0; i < 2; ++i) { int R, C; stage_rc(tid * 16 + i * 8192, R, C); voffA[i] = (unsigned)(R * K + C) * 2u; }
    const size_t kstep = (size_t)(BK * 2);
    const size_t hstep = (size_t)HALF * K * 2;
    const size_t tstep = 2 * hstep;
    const unsigned ldsw = (unsigned)wid * 1024u;
    const int aoff = lds_byte(wr * 64 + fr, fq * 8), boff = lds_byte(wc * 32 + fr, fq * 8);
#define PG8_SA(b, h) (((b) * 2 + (h)) * HTB)
#define PG8_SB(b, h) ((4 + (b) * 2 + (h)) * HTB)
#define PG8_STAGE(bufoff, gbase) do { _Pragma("unroll") for (int _i = 0; _i < 2; ++_i) \
        __builtin_amdgcn_global_load_lds((const unsigned*)((const char*)(gbase) + voffA[_i]), (LAS unsigned*)(lds + (bufoff) + ldsw + _i * 8192), 16, 0, 0); } while (0)
#define PG8_LDA(dst, b, h) do { _Pragma("unroll") for (int m = 0; m < 4; ++m) _Pragma("unroll") for (int k = 0; k < 2; ++k) dst[m][k] = *(const LAS bf16x8*)(lds + PG8_SA(b, h) + aoff + m * 2048 + k * 1024); } while (0)
#define PG8_LDB(dst, b, h) do { _Pragma("unroll") for (int n = 0; n < 2; ++n) _Pragma("unroll") for (int k = 0; k < 2; ++k) dst[n][k] = *(const LAS bf16x8*)(lds + PG8_SB(b, h) + boff + n * 2048 + k * 1024); } while (0)
#define PG8_MMA(ai, bj, At, Bt) do { __builtin_amdgcn_s_setprio(1); _Pragma("unroll") for (int m = 0; m < 4; ++m) _Pragma("unroll") for (int n = 0; n < 2; ++n) _Pragma("unroll") for (int k = 0; k < 2; ++k) \
        acc[ai][bj][m][n] = __builtin_amdgcn_mfma_f32_16x16x32_bf16(Bt[n][k], At[m][k], acc[ai][bj][m][n], 0, 0, 0); __builtin_amdgcn_s_setprio(0); } while (0)
#define PG8_WAIT_V(n) asm volatile("s_waitcnt vmcnt(" #n ")" ::: "memory")
#define PG8_WAIT_L(n) asm volatile("s_waitcnt lgkmcnt(" #n ")" ::: "memory")
#define PG8_BAR __builtin_amdgcn_s_barrier()
#define PG8_SCHED __builtin_amdgcn_sched_barrier(0)
    Unit cur, nxt; int ui = 0;
    if (!S.next(0, cur)) return;
    f32x4 acc[2][2][4][2];
#pragma unroll
    for (int a = 0; a < 2; ++a)
#pragma unroll
        for (int b = 0; b < 2; ++b)
#pragma unroll
            for (int m = 0; m < 4; ++m)
#pragma unroll
                for (int n = 0; n < 2; ++n) acc[a][b][m][n] = (f32x4){0.f, 0.f, 0.f, 0.f};
    bf16x8 At[4][2], B0[2][2], B1[2][2];
    const char* cA = (const char*)g.A + (size_t)cur.pm * tstep + (size_t)cur.kt0 * kstep; const char* cB = (const char*)g.Bt + (size_t)cur.pn * tstep + (size_t)cur.kt0 * kstep;
    PG8_STAGE(PG8_SB(0, 0), cB); PG8_STAGE(PG8_SB(0, 1), cB + hstep); PG8_STAGE(PG8_SA(0, 0), cA); PG8_STAGE(PG8_SA(0, 1), cA + hstep);
    if (wr == 1) PG8_BAR;
    PG8_WAIT_V(2); PG8_BAR;
    PG8_STAGE(PG8_SB(1, 0), cB + kstep); PG8_STAGE(PG8_SA(1, 0), cA + kstep); PG8_STAGE(PG8_SB(1, 1), cB + hstep + kstep);
    PG8_WAIT_V(6); PG8_BAR;
    for (;;) {
        const bool has_next = S.next(ui + 1, nxt);
        const char* nA = has_next ? (const char*)g.A + (size_t)nxt.pm * tstep + (size_t)nxt.kt0 * kstep : cA; const char* nB = has_next ? (const char*)g.Bt + (size_t)nxt.pn * tstep + (size_t)nxt.kt0 * kstep : cB;
        const int nt = cur.nkt;
        for (int t = 0; t < nt; t += 2) {
            const bool last = (t == nt - 2);
            const char* a1 = cA + (size_t)(t + 1) * kstep;
            const char* a2 = last ? nA : cA + (size_t)(t + 2) * kstep; const char* b2 = last ? nB : cB + (size_t)(t + 2) * kstep;
            const char* a3 = a2 + kstep; const char* b3 = b2 + kstep;
            PG8_LDB(B0, 0, 0); PG8_LDB(B1, 0, 1); PG8_SCHED; PG8_LDA(At, 0, 0); PG8_STAGE(PG8_SA(1, 1), a1 + hstep);
            PG8_WAIT_V(8); PG8_WAIT_L(0); PG8_BAR; PG8_MMA(0, 0, At, B0); PG8_MMA(0, 1, At, B1); PG8_BAR; PG8_SCHED;
            PG8_LDA(At, 0, 1); PG8_STAGE(PG8_SB(0, 0), b2); PG8_STAGE(PG8_SB(0, 1), b2 + hstep); PG8_STAGE(PG8_SA(0, 0), a2);
            PG8_WAIT_V(8); PG8_WAIT_L(0); PG8_BAR; PG8_MMA(1, 0, At, B0); PG8_MMA(1, 1, At, B1); PG8_BAR; PG8_SCHED;
            PG8_LDB(B0, 1, 0); PG8_LDB(B1, 1, 1); PG8_SCHED; PG8_LDA(At, 1, 0); PG8_STAGE(PG8_SA(0, 1), a2 + hstep);
            PG8_WAIT_V(8); PG8_WAIT_L(0); PG8_BAR; PG8_MMA(0, 0, At, B0); PG8_MMA(0, 1, At, B1); PG8_BAR; PG8_SCHED;
            PG8_LDA(At, 1, 1); PG8_STAGE(PG8_SB(1, 0), b3); PG8_STAGE(PG8_SB(1, 1), b3 + hstep); PG8_STAGE(PG8_SA(1, 0), a3);
            PG8_WAIT_V(8); PG8_WAIT_L(0); PG8_BAR; PG8_MMA(1, 0, At, B0); PG8_MMA(1, 1, At, B1); PG8_BAR; PG8_SCHED;
        }
        if (wr == 0) PG8_BAR;
        int rg0 = 0, rg1 = 8;
        if (cur.sf > 1) {
            {
                const int si = cur.sq * cur.sf + cur.sj;
                u32x4* slot = (u32x4*)((si < sc.n0 ? sc.part0 + (size_t)si * 65536 : sc.part1 + (size_t)(si - sc.n0) * 65536)) + tid;
#pragma unroll
                for (int a = 0; a < 2; ++a)
#pragma unroll
                    for (int m = 0; m < 4; ++m)
#pragma unroll
                        for (int b = 0; b < 2; ++b) {
                            const f32x4 v0 = acc[a][b][m][0], v1 = acc[a][b][m][1];
                            u32x4 w; w.x = pk2(v0[0], v0[1]); w.y = pk2(v0[2], v0[3]); w.z = pk2(v1[0], v1[1]); w.w = pk2(v1[2], v1[3]);
                            *slot = w; slot += 512; asm volatile("" : "+v"(slot));
                        }
            }
            asm volatile("s_waitcnt vmcnt(0)" ::: "memory");
            __syncthreads();
            if (tid == 0) {
                __builtin_amdgcn_fence(__ATOMIC_RELEASE, "agent");
                asm volatile("s_waitcnt vmcnt(0)" ::: "memory");
                unsigned* cw = sc.ctr + 16 * cur.sq;
                (void)__hip_atomic_fetch_add(cw, 1u, __ATOMIC_RELAXED, __HIP_MEMORY_SCOPE_AGENT);
                unsigned sp = 0;
                while (__hip_atomic_load(cw, __ATOMIC_RELAXED, __HIP_MEMORY_SCOPE_AGENT) < (unsigned)cur.sf) { __builtin_amdgcn_s_sleep(1); if (++sp > (1u << 22)) break; }
                __builtin_amdgcn_fence(__ATOMIC_ACQUIRE, "agent");
                asm volatile("s_waitcnt vmcnt(0)" ::: "memory");
            }
            __syncthreads();
            rg0 = 8 * cur.sj / cur.sf; rg1 = 8 * (cur.sj + 1) / cur.sf;
#pragma unroll
            for (int a = 0; a < 2; ++a)
#pragma unroll
                for (int m = 0; m < 4; ++m) {
                    if (a * 4 + m < rg0 || a * 4 + m >= rg1) continue;
                    f32x4 t00 = (f32x4){0.f, 0.f, 0.f, 0.f}, t01 = t00, t10 = t00, t11 = t00;
#pragma unroll 2
                    for (int j = 0; j < cur.sf; ++j) {
                        const int si = cur.sq * cur.sf + j;
                        const u32x4* slot = (const u32x4*)((si < sc.n0 ? sc.part0 + (size_t)si * 65536 : sc.part1 + (size_t)(si - sc.n0) * 65536)) + tid + (size_t)(a * 4 + m) * 1024;
                        const u32x4 w0 = slot[0], w1 = slot[512];
                        t00 += (f32x4){bf_lo(w0.x), bf_hi(w0.x), bf_lo(w0.y), bf_hi(w0.y)}; t01 += (f32x4){bf_lo(w0.z), bf_hi(w0.z), bf_lo(w0.w), bf_hi(w0.w)};
                        t10 += (f32x4){bf_lo(w1.x), bf_hi(w1.x), bf_lo(w1.y), bf_hi(w1.y)}; t11 += (f32x4){bf_lo(w1.z), bf_hi(w1.z), bf_lo(w1.w), bf_hi(w1.w)};
                    }
                    acc[a][0][m][0] = t00; acc[a][0][m][1] = t01; acc[a][1][m][0] = t10; acc[a][1][m][1] = t11;
                }
        }
        E(acc, cur, wr, wc, fr, fq, rg0, rg1);
        if (!has_next) break;
#pragma unroll
        for (int a = 0; a < 2; ++a)
#pragma unroll
            for (int b = 0; b < 2; ++b)
#pragma unroll
                for (int m = 0; m < 4; ++m)
#pragma unroll
                    for (int n = 0; n < 2; ++n) acc[a][b][m][n] = (f32x4){0.f, 0.f, 0.f, 0.f};
        cur = nxt; cA = nA; cB = nB; ++ui;
        if (wr == 1) PG8_BAR;
    }
    PG8_WAIT_V(0);
    PG8_BAR;
#undef PG8_SA
#undef PG8_SB
#undef PG8_STAGE
#undef PG8_LDA
#undef PG8_LDB
#undef PG8_MMA
#undef PG8_WAIT_V
#undef PG8_WAIT_L
#undef PG8_BAR
#undef PG8_SCHED
}
}
using pg8::Unit;

typedef f32x4 Acc[2][2][4][2];

struct EpiProj {
    bf16_t *Q, *Kb, *Vb, *U, *G; float* gss; const float* rope; const float *qn, *kn; float* out;
    __device__ __forceinline__ void operator()(const Acc& acc, const Unit& u, int wr, int wc, int fr, int fq, int rg0, int rg1) const {
        const int pn = u.pn;
        const int rbase = u.pm * 256 + wr * 64 + fr;
        if (pn < 5) {
            const bool isq = pn < 4;
            const float* nw = (isq ? qn : kn) + 8 * fq;
            const f32x4 w00 = *(const f32x4*)(nw), w01 = *(const f32x4*)(nw + 4), w10 = *(const f32x4*)(nw + 32), w11 = *(const f32x4*)(nw + 36);
            const float osc = isq ? 0.125f : 1.0f;
#pragma unroll
            for (int ai = 0; ai < 2; ++ai)
#pragma unroll
                for (int m = 0; m < 4; ++m) {
                if (ai * 4 + m < rg0 || ai * 4 + m >= rg1) continue;
                    if (ai * 4 + m < rg0 || ai * 4 + m >= rg1) continue;
                    const int row = rbase + ai * 128 + m * 16;
                    float ss = 0.f;
#pragma unroll
                    for (int bj = 0; bj < 2; ++bj)
#pragma unroll
                        for (int n = 0; n < 2; ++n) { const f32x4 v = acc[ai][bj][m][n]; ss += (v[0] * v[0] + v[1] * v[1]) + (v[2] * v[2] + v[3] * v[3]); }
                    ss = fq_sum(ss);
                    const float r = rsqrtf(ss * (1.0f / 64.0f) + EPS);
                    const int pidx = row < MP ? (row & 2047) : 2048 + (row & 7);
                    const float* rp = rope + pidx * 64 + 8 * fq;
                    const f32x4 c0 = *(const f32x4*)(rp), c1 = *(const f32x4*)(rp + 4), s0 = *(const f32x4*)(rp + 32), s1 = *(const f32x4*)(rp + 36);
                    const f32x4 x10 = acc[ai][0][m][0] * w00 * r, x11 = acc[ai][0][m][1] * w01 * r, x20 = acc[ai][1][m][0] * w10 * r, x21 = acc[ai][1][m][1] * w11 * r;
                    const f32x4 o10 = (x10 * c0 - x20 * s0) * osc, o11 = (x11 * c1 - x21 * s1) * osc, o20 = (x20 * c0 + x10 * s0) * osc, o21 = (x21 * c1 + x11 * s1) * osc;
                    u32x4 lo, hi;
                    lo.x = pk2(o10[0], o10[1]); lo.y = pk2(o10[2], o10[3]); lo.z = pk2(o11[0], o11[1]); lo.w = pk2(o11[2], o11[3]);
                    hi.x = pk2(o20[0], o20[1]); hi.y = pk2(o20[2], o20[3]); hi.z = pk2(o21[0], o21[1]); hi.w = pk2(o21[2], o21[3]);
                    if (isq) {
                        bf16_t* d = Q + (size_t)row * AW + (4 * pn + wc) * 64 + 8 * fq;
                        *(u32x4*)d = lo; *(u32x4*)(d + 32) = hi;
                    } else {
                        bf16_t* d = Kb + (size_t)row * KVW + wc * 64 + 8 * fq;
                        *(u32x4*)d = lo; *(u32x4*)(d + 32) = hi;
                        float* wdst = nullptr;
                        if (row >= MP) { const int rr = row - MP; wdst = out + OUT_KWS + ((size_t)((rr >> 3) * 128 + 120 + (rr & 7)) * 4 + wc) * 64 + 8 * fq; }
                        else if ((row & 2047) >= 1920) wdst = out + OUT_KWP + ((size_t)((row >> 11) * 128 + (row & 2047) - 1920) * 4 + wc) * 64 + 8 * fq;
                        if (wdst) { *(f32x4*)wdst = o10; *(f32x4*)(wdst + 4) = o11; *(f32x4*)(wdst + 32) = o20; *(f32x4*)(wdst + 36) = o21; }
                    }
                }
        } else if (pn == 5) {
#pragma unroll
            for (int ai = 0; ai < 2; ++ai)
#pragma unroll
                for (int m = 0; m < 4; ++m) {
                if (ai * 4 + m < rg0 || ai * 4 + m >= rg1) continue;
                    if (ai * 4 + m < rg0 || ai * 4 + m >= rg1) continue;
                    const int row = rbase + ai * 128 + m * 16;
                    float* wdst = nullptr;
                    if (row >= MP) { const int rr = row - MP; wdst = out + OUT_VWS + ((size_t)((rr >> 3) * 128 + 120 + (rr & 7)) * 4 + wc) * 64 + 8 * fq; }
                    else if ((row & 2047) >= 1920) wdst = out + OUT_VWP + ((size_t)((row >> 11) * 128 + (row & 2047) - 1920) * 4 + wc) * 64 + 8 * fq;
#pragma unroll
                    for (int bj = 0; bj < 2; ++bj) {
                        const f32x4 v0 = acc[ai][bj][m][0], v1 = acc[ai][bj][m][1];
                        u32x4 w; w.x = pk2(v0[0], v0[1]); w.y = pk2(v0[2], v0[3]); w.z = pk2(v1[0], v1[1]); w.w = pk2(v1[2], v1[3]);
                        *(u32x4*)(Vb + (size_t)row * KVW + wc * 64 + 32 * bj + 8 * fq) = w;
                        if (wdst) { *(f32x4*)(wdst + 32 * bj) = v0; *(f32x4*)(wdst + 32 * bj + 4) = v1; }
                    }
                }
        } else {
            const bool isg = pn >= 10;
            bf16_t* dst = isg ? G : U; const int ct = isg ? pn - 10 : pn - 6;
#pragma unroll
            for (int ai = 0; ai < 2; ++ai)
#pragma unroll
                for (int m = 0; m < 4; ++m) {
                if (ai * 4 + m < rg0 || ai * 4 + m >= rg1) continue;
                    if (ai * 4 + m < rg0 || ai * 4 + m >= rg1) continue;
                    const int row = rbase + ai * 128 + m * 16;
                    float ss = 0.f;
#pragma unroll
                    for (int bj = 0; bj < 2; ++bj) {
                        f32x4 v0 = acc[ai][bj][m][0], v1 = acc[ai][bj][m][1];
                        { const f32x2 a = gelu2((f32x2){v0[0], v0[1]}), b2 = gelu2((f32x2){v0[2], v0[3]}), c2 = gelu2((f32x2){v1[0], v1[1]}), d2 = gelu2((f32x2){v1[2], v1[3]});
                          v0 = (f32x4){a.x, a.y, b2.x, b2.y}; v1 = (f32x4){c2.x, c2.y, d2.x, d2.y}; }
                        ss += (v0[0] * v0[0] + v0[1] * v0[1]) + (v0[2] * v0[2] + v0[3] * v0[3]) + (v1[0] * v1[0] + v1[1] * v1[1]) + (v1[2] * v1[2] + v1[3] * v1[3]);
                        u32x4 w; w.x = pk2(v0[0], v0[1]); w.y = pk2(v0[2], v0[3]); w.z = pk2(v1[0], v1[1]); w.w = pk2(v1[2], v1[3]);
                        *(u32x4*)(dst + (size_t)row * SGW + ct * 256 + wc * 64 + 32 * bj + 8 * fq) = w;
                    }
                    if (isg) { ss = fq_sum(ss); if (fq == 0) gss[(size_t)row * 16 + ct * 4 + wc] = ss; }
                }
        }
    }
};

struct EpiWo {
    Params p; bf16_t* HB; float* hss;
    __device__ __forceinline__ void operator()(const Acc& acc, const Unit& u, int wr, int wc, int fr, int fq, int rg0, int rg1) const {
        const int rbase = u.pm * 256 + wr * 64 + fr, cb = u.pn * 256 + wc * 64 + 8 * fq;
#pragma unroll
        for (int ai = 0; ai < 2; ++ai)
#pragma unroll
        for (int mh = 0; mh < 2; ++mh) {
            f32x4 xv[4][2][2];
#pragma unroll
            for (int m = 2 * mh; m < 2 * mh + 2; ++m) {
                if (ai * 4 + m < rg0 || ai * 4 + m >= rg1) continue;
                const float* xr = xrow(p, rbase + ai * 128 + m * 16) + cb;
#pragma unroll
                for (int bj = 0; bj < 2; ++bj) { xv[m][bj][0] = *(const f32x4*)(xr + 32 * bj); xv[m][bj][1] = *(const f32x4*)(xr + 32 * bj + 4); }
            }
#pragma unroll
            for (int m = 2 * mh; m < 2 * mh + 2; ++m) {
                if (ai * 4 + m < rg0 || ai * 4 + m >= rg1) continue;
                const int row = rbase + ai * 128 + m * 16;
                float ss = 0.f;
#pragma unroll
                for (int bj = 0; bj < 2; ++bj) {
                    const f32x4 h0 = xv[m][bj][0] + acc[ai][bj][m][0], h1 = xv[m][bj][1] + acc[ai][bj][m][1];
                    ss += (h0[0] * h0[0] + h0[1] * h0[1]) + (h0[2] * h0[2] + h0[3] * h0[3]) + (h1[0] * h1[0] + h1[1] * h1[1]) + (h1[2] * h1[2] + h1[3] * h1[3]);
                    u32x4 w; w.x = pk2(h0[0], h0[1]); w.y = pk2(h0[2], h0[3]); w.z = pk2(h1[0], h1[1]); w.w = pk2(h1[2], h1[3]);
                    *(u32x4*)(HB + (size_t)row * DM + cb + 32 * bj) = w;
                }
                ss = fq_sum(ss);
                if (fq == 0) hss[(size_t)row * 32 + u.pn * 4 + wc] = ss;
            }
        }
    }
};

struct EpiGU {
    const float* hss; bf16_t* ACT;
    __device__ __forceinline__ void operator()(const Acc& acc, const Unit& u, int wr, int wc, int fr, int fq, int rg0, int rg1) const {
        const int rbase = u.pm * 256 + wr * 64 + fr, cb = u.pn * 128 + wc * 32 + 8 * fq;
        float r8[8];
#pragma unroll
        for (int ai = 0; ai < 2; ++ai)
#pragma unroll
            for (int m = 0; m < 4; ++m) {
                r8[ai * 4 + m] = 0.f;
                if (ai * 4 + m < rg0 || ai * 4 + m >= rg1) continue;
                const f32x4* hp = (const f32x4*)(hss + (size_t)(rbase + ai * 128 + m * 16) * 32) + 2 * fq;
                const f32x4 t = hp[0] + hp[1];
                r8[ai * 4 + m] = (t[0] + t[1]) + (t[2] + t[3]);
            }
#pragma unroll
        for (int ai = 0; ai < 2; ++ai)
#pragma unroll
            for (int m = 0; m < 4; ++m) {
                if (ai * 4 + m < rg0 || ai * 4 + m >= rg1) continue;
                const int row = rbase + ai * 128 + m * 16;
                const float r = rsqrtf(fq_sum(r8[ai * 4 + m]) * (1.0f / DM) + EPS);
                const f32x4 g0 = acc[ai][0][m][0] * r, g1 = acc[ai][0][m][1] * r, u0 = acc[ai][1][m][0] * r, u1 = acc[ai][1][m][1] * r;
                const f32x2 p0 = silu_mul2((f32x2){g0[0], g0[1]}, (f32x2){u0[0], u0[1]}), p1 = silu_mul2((f32x2){g0[2], g0[3]}, (f32x2){u0[2], u0[3]});
                const f32x2 p2 = silu_mul2((f32x2){g1[0], g1[1]}, (f32x2){u1[0], u1[1]}), p3 = silu_mul2((f32x2){g1[2], g1[3]}, (f32x2){u1[2], u1[3]});
                const f32x4 a0 = (f32x4){p0.x, p0.y, p1.x, p1.y}, a1 = (f32x4){p2.x, p2.y, p3.x, p3.y};
                u32x4 w; w.x = pk2(a0[0], a0[1]); w.y = pk2(a0[2], a0[3]); w.z = pk2(a1[0], a1[1]); w.w = pk2(a1[2], a1[3]);
                *(u32x4*)(ACT + (size_t)row * FF + cb) = w;
            }
    }
};

struct EpiDown {
    float* out; const bf16_t* HB;
    __device__ __forceinline__ void operator()(const Acc& acc, const Unit& u, int wr, int wc, int fr, int fq, int rg0, int rg1) const {
        const int rbase = u.pm * 256 + wr * 64 + fr, cb = u.pn * 256 + wc * 64 + 8 * fq;
#pragma unroll
        for (int ai = 0; ai < 2; ++ai) {
            u32x4 hv[4][2];
#pragma unroll
            for (int m = 0; m < 4; ++m) {
                if (ai * 4 + m < rg0 || ai * 4 + m >= rg1) continue;
                const bf16_t* hr = HB + (size_t)(rbase + ai * 128 + m * 16) * DM + cb;
#pragma unroll
                for (int bj = 0; bj < 2; ++bj) hv[m][bj] = *(const u32x4*)(hr + 32 * bj);
            }
#pragma unroll
            for (int m = 0; m < 4; ++m) {
                if (ai * 4 + m < rg0 || ai * 4 + m >= rg1) continue;
                float* yr = out + OUT_Y + (size_t)(rbase + ai * 128 + m * 16) * DM + cb;
#pragma unroll
                for (int bj = 0; bj < 2; ++bj) {
                    const u32x4 w = hv[m][bj];
                    const f32x4 h0 = (f32x4){bf_lo(w.x), bf_hi(w.x), bf_lo(w.y), bf_hi(w.y)}, h1 = (f32x4){bf_lo(w.z), bf_hi(w.z), bf_lo(w.w), bf_hi(w.w)};
                    __builtin_nontemporal_store(h0 + acc[ai][bj][m][0], (f32x4*)(yr + 32 * bj)); __builtin_nontemporal_store(h1 + acc[ai][bj][m][1], (f32x4*)(yr + 32 * bj + 4));
                }
            }
        }
    }
};

__device__ __forceinline__ void p0_transpose_item(const float* W, int K, int N, bf16_t* WT, int mode, const float* s0, const float* s1, int split,
                                                  LAS float* scr, int item, int lane) {
    const int nblk = N / 32, kb = item / nblk, nb = item % nblk, k0 = 64 * kb, n0 = 32 * nb;
#pragma unroll 8
    for (int i = 0; i < 32; ++i) { const int kk = 2 * i + (lane >> 5); scr[kk * 33 + (lane & 31)] = __builtin_nontemporal_load(W + (size_t)(k0 + kk) * N + n0 + (lane & 31)); }
    asm volatile("s_waitcnt lgkmcnt(0)" ::: "memory");
    const int c = lane & 7;
    float sc[8];
#pragma unroll
    for (int e = 0; e < 8; ++e) { const int k = k0 + 8 * c + e; sc[e] = s0 ? (k < split ? s0[k] : s1[k - split]) : 1.0f; }
    int rowbase;
    if (mode == 0) rowbase = (n0 >> 8) * 256 + ((n0 >> 5) & 1) * 128 + ((n0 >> 6) & 3) * 32;
    else rowbase = (n0 >> 7) * 256 + (mode - 1) * 128 + ((n0 >> 5) & 3) * 32;
#pragma unroll
    for (int j = 0; j < 4; ++j) {
        const int n = (lane >> 3) + 8 * j; const LAS float* s = scr + (8 * c) * 33 + n;
        const int pr = 16 * ((n >> 2) & 1) + 4 * (n >> 3) + (n & 3);
        u32x4 o; o.x = pk2(s[0 * 33] * sc[0], s[1 * 33] * sc[1]); o.y = pk2(s[2 * 33] * sc[2], s[3 * 33] * sc[3]); o.z = pk2(s[4 * 33] * sc[4], s[5 * 33] * sc[5]); o.w = pk2(s[6 * 33] * sc[6], s[7 * 33] * sc[7]);
        *(u32x4*)(WT + (size_t)(rowbase + pr) * K + k0 + 8 * c) = o;
    }
    asm volatile("s_waitcnt lgkmcnt(0)" ::: "memory");
}

__device__ __forceinline__ void sincos_pi(double r, double& s, double& c) {
    const double x2 = r * r;
    double ps = -1.0 / 1.0888869450418352e28;
    ps = ps * x2 + 1.0 / 1.5511210043330986e25;
    ps = ps * x2 - 1.0 / 2.585201673888498e22;
    ps = ps * x2 + 1.0 / 5.109094217170944e19;
    ps = ps * x2 - 1.0 / 1.21645100408832e17;
    ps = ps * x2 + 1.0 / 3.55687428096e14;
    ps = ps * x2 - 1.0 / 1.307674368e12;
    ps = ps * x2 + 1.0 / 6.2270208e9;
    ps = ps * x2 - 1.0 / 3.99168e7;
    ps = ps * x2 + 1.0 / 362880.0;
    ps = ps * x2 - 1.0 / 5040.0;
    ps = ps * x2 + 1.0 / 120.0;
    ps = ps * x2 - 1.0 / 6.0;
    ps = ps * x2 + 1.0;
    s = ps * r;
    double pc = -1.0 / 4.0329146112660565e26;
    pc = pc * x2 + 1.0 / 6.204484017332394e23;
    pc = pc * x2 - 1.0 / 1.1240007277776077e21;
    pc = pc * x2 + 1.0 / 2.43290200817664e18;
    pc = pc * x2 - 1.0 / 6.402373705728e15;
    pc = pc * x2 + 1.0 / 2.0922789888e13;
    pc = pc * x2 - 1.0 / 8.71782912e10;
    pc = pc * x2 + 1.0 / 4.790016e8;
    pc = pc * x2 - 1.0 / 3628800.0;
    pc = pc * x2 + 1.0 / 40320.0;
    pc = pc * x2 - 1.0 / 720.0;
    pc = pc * x2 + 1.0 / 24.0;
    pc = pc * x2 - 0.5;
    pc = pc * x2 + 1.0;
    c = pc;
}

__device__ __forceinline__ void p0_prologue(const Params& p, LAS unsigned char* lds) {
    const int tid = opaque(threadIdx.x), lane = tid & 63, wave = __builtin_amdgcn_readfirstlane(tid >> 6);
    unsigned char* ws = p.ws;
    const int G = gridDim.x, gw = blockIdx.x * 8 + wave, NGW = G * 8;
    LAS float* scr = (LAS float*)(lds + wave * 16384);
    constexpr int I_IN = (DM / 64) * (INW / 32), I_O = (DM / 64) * (DM / 32), I_G = (DM / 64) * (FF / 32), I_D = (FF / 64) * (DM / 32);
    constexpr int NITEMS = I_IN + I_O + 2 * I_G + I_D;
    for (int it = gw; it < NITEMS; it += NGW) {
        int r = it;
        if (r < I_IN) { p0_transpose_item(p.w_in, DM, INW, (bf16_t*)(ws + OFF_WIN), 0, nullptr, nullptr, 0, scr, r, lane); continue; } r -= I_IN;
        if (r < I_O) { p0_transpose_item(p.w_o, DM, DM, (bf16_t*)(ws + OFF_WO), 0, p.attn_out_norm, p.sg_out_norm, AW, scr, r, lane); continue; } r -= I_O;
        if (r < I_G) { p0_transpose_item(p.w_gate, DM, FF, (bf16_t*)(ws + OFF_WGU), 1, p.ffn_norm, p.ffn_norm, DM, scr, r, lane); continue; } r -= I_G;
        if (r < I_G) { p0_transpose_item(p.w_up, DM, FF, (bf16_t*)(ws + OFF_WGU), 2, p.ffn_norm, p.ffn_norm, DM, scr, r, lane); continue; } r -= I_G;
        p0_transpose_item(p.w_down, FF, DM, (bf16_t*)(ws + OFF_WDN), 0, nullptr, nullptr, 0, scr, r, lane);
    }
    bf16_t* XN = (bf16_t*)(ws + OFF_XN);
    for (int m = gw; m < MT; m += NGW) {
        const f32x4* xr = (const f32x4*)xrow(p, m) + lane;
        f32x4 v[8]; float s = 0.f;
#pragma unroll
        for (int j = 0; j < 8; ++j) { v[j] = xr[64 * j]; s += (v[j][0] * v[j][0] + v[j][1] * v[j][1]) + (v[j][2] * v[j][2] + v[j][3] * v[j][3]); }
        const float r = rsqrtf(wave_sum(s) * (1.0f / DM) + EPS);
        u32x2* o8 = (u32x2*)(XN + (size_t)m * DM) + lane;
#pragma unroll
        for (int j = 0; j < 8; ++j) { const f32x4 w = ((const f32x4*)p.attn_norm)[lane + 64 * j]; const f32x4 y = v[j] * r * w; u32x2 o; o.x = pk2(y[0], y[1]); o.y = pk2(y[2], y[3]); o8[64 * j] = o; }
    }
    const int gt = blockIdx.x * 512 + tid, NT = G * 512;
    float* rope = (float*)(ws + OFF_ROPE);
    for (int e = gt; e < NROPE * 32; e += NT) {
        const int pi = e >> 5, i = e & 31;
        const double pos = pi < 2048 ? (double)pi : (double)(16384 + pi - 2048);
        const double a = pos * ROPE_INV[i];
        const double k = __builtin_rint(a * 0.15915494309189535);
        double r = __builtin_fma(-k, 6.283185307179586, a); r = __builtin_fma(-k, 2.4492935982947064e-16, r);
        double s, c; sincos_pi(r, s, c);
        rope[pi * 64 + i] = (float)c; rope[pi * 64 + 32 + i] = (float)s;
    }
    bf16_t* wsg = (bf16_t*)(ws + OFF_WSG);
    for (int e = gt; e < 8 * 128 * 128 / 2; e += NT) {
        const int idx = 2 * e, j = idx & 127, i = (idx >> 7) & 127;
        const float a = j <= i ? p.sg_w[idx] : 0.f, b = (j + 1) <= i ? p.sg_w[idx + 1] : 0.f;
        ((unsigned*)wsg)[e] = pk2(a, b);
    }
}

constexpr int KROW = 144;
constexpr int KVH_BYTES = 160 * KROW;
constexpr int GROW = 544;
constexpr int L_K = 0, L_V = 2 * KVH_BYTES, L_RED = 4 * KVH_BYTES  , L_RG = L_RED + 32 * 8 * 4;
constexpr int GBUF = 128 * GROW  , L_RED2 = 2 * GBUF  , L_RG2 = L_RED2 + 32 * 8 * 4;

__device__ __forceinline__ s16x4 ldtr(const LAS unsigned char* p) { return __builtin_bit_cast(s16x4, __builtin_amdgcn_ds_read_tr16_b64_v4i16((LAS s16x4*)p)); }

template <int NQB>
__device__ __forceinline__ void attn_core(const LAS unsigned char* Kl, const LAS unsigned char* Vl, const bf16x8 (&qf)[NQB][2], float sink, int kmin,
                                          f32x4 (&o)[NQB][4], int lane) {
    const int fr = lane & 15, fq = lane >> 4, tq = (lane & 15) >> 2, tp = lane & 3;
#pragma unroll
    for (int qb = 0; qb < NQB; ++qb) {
        asm volatile("" ::: "memory");
        const int qi = 16 * qb + fr;
        const bf16x8 q0 = qf[qb][0], q1 = qf[qb][1];
        f32x4 s[10];
#pragma unroll
        for (int t = 0; t < 10; ++t) {
            const LAS unsigned char* kp = Kl + (16 * t + fr) * KROW + 16 * fq;
            const bf16x8 k0 = *(const LAS bf16x8*)kp, k1 = *(const LAS bf16x8*)(kp + 64);
            s[t] = __builtin_amdgcn_mfma_f32_16x16x32_bf16(k0, q0, (f32x4){0.f, 0.f, 0.f, 0.f}, 0, 0, 0);
            s[t] = __builtin_amdgcn_mfma_f32_16x16x32_bf16(k1, q1, s[t], 0, 0, 0);
            if (t & 1) __builtin_amdgcn_sched_barrier(0);
        }
        float mx = -INFINITY;
#pragma unroll
        for (int t = 0; t < 10; ++t)
#pragma unroll
            for (int j = 0; j < 4; ++j) {
                const int kj = 16 * t + 4 * fq + j, diff = 128 + qi - kj;
                const bool valid = (diff >= 0) && (diff < 128) && (kj >= kmin);
                s[t][j] = valid ? s[t][j] : -INFINITY;
                mx = fmaxf(mx, s[t][j]);
            }
        mx = fmaxf(fq_max(mx), sink);
        float sum = 0.f;
#pragma unroll
        for (int t = 0; t < 10; ++t)
#pragma unroll
            for (int j = 0; j < 4; ++j) { const float e = __expf(s[t][j] - mx); s[t][j] = e; sum += e; }
        sum = fq_sum(sum) + __expf(sink - mx);
        const float inv = 1.0f / sum;
#pragma unroll
        for (int dt = 0; dt < 4; ++dt) o[qb][dt] = (f32x4){0.f, 0.f, 0.f, 0.f};
#pragma unroll
        for (int T = 0; T < 5; ++T) {
            u32x4 pw; pw.x = pk2(s[2 * T][0] * inv, s[2 * T][1] * inv); pw.y = pk2(s[2 * T][2] * inv, s[2 * T][3] * inv);
            pw.z = pk2(s[2 * T + 1][0] * inv, s[2 * T + 1][1] * inv); pw.w = pk2(s[2 * T + 1][2] * inv, s[2 * T + 1][3] * inv);
            const bf16x8 pf = __builtin_bit_cast(bf16x8, pw);
            const LAS unsigned char* vp = Vl + (32 * T + 4 * fq + tq) * KROW + 8 * tp;
#pragma unroll
            for (int dt = 0; dt < 4; ++dt) {
                const s16x4 lo = ldtr(vp + 32 * dt), hi = ldtr(vp + 16 * KROW + 32 * dt);
                const bf16x8 vf = __builtin_shufflevector(lo, hi, 0, 1, 2, 3, 4, 5, 6, 7);
                o[qb][dt] = __builtin_amdgcn_mfma_f32_16x16x32_bf16(vf, pf, o[qb][dt], 0, 0, 0);
            }
            __builtin_amdgcn_sched_barrier(0);
        }
    }
}

template <int NQB>
__device__ __forceinline__ void load_q(bf16x8 (&qf)[NQB][2], const bf16_t* Qg  , int nq, int lane) {
    const int fr = lane & 15, fq = lane >> 4;
#pragma unroll
    for (int qb = 0; qb < NQB; ++qb) {
        const int qi = 16 * qb + fr, qic = qi < nq ? qi : nq - 1;
        const bf16_t* qp = Qg + (size_t)qic * AW + 8 * fq;
        qf[qb][0] = *(const bf16x8*)qp; qf[qb][1] = *(const bf16x8*)(qp + 32);
    }
}
__device__ __forceinline__ float rowscale16(const float* ss16) {
    const f32x4* q = (const f32x4*)ss16; const f32x4 t = (q[0] + q[1]) + (q[2] + q[3]);
    return rsqrtf(((t[0] + t[1]) + (t[2] + t[3])) * (1.0f / 1024.0f) + EPS);
}

__device__ __forceinline__ void p2_prompt_att(const Params& p, LAS unsigned char* lds, int unit) {
    const int tid = opaque(threadIdx.x), lane = tid & 63, wave = __builtin_amdgcn_readfirstlane(tid >> 6);
    unsigned char* ws = p.ws;
    const bf16_t* Q = (const bf16_t*)(ws + OFF_Q); const bf16_t* Kb = (const bf16_t*)(ws + OFF_KB); const bf16_t* Vb = (const bf16_t*)(ws + OFF_VB);
    const bf16_t* U = (const bf16_t*)(ws + OFF_U); const bf16_t* Gm = (const bf16_t*)(ws + OFF_G); bf16_t* MIX = (bf16_t*)(ws + OFF_MIX);
    const float* gss = (const float*)(ws + OFF_GSS); const bf16_t* wsg = (const bf16_t*)(ws + OFF_WSG);
    const int b = unit >> 6, s0 = (unit & 63) * 32, row0 = b * 2048 + s0;
    const int fr = lane & 15, fq = lane >> 4, tq = (lane & 15) >> 2, tp = lane & 3;
    LAS float* red = (LAS float*)(lds + L_RED);
    LAS float* rgl = (LAS float*)(lds + L_RG);
    {
        f32x4 o[2][2][4];
        const int kmin = s0 < 128 ? 128 - s0 : 0;
        u32x4 kr[5], vr[5];
#define ATT_LOADKV(ps_) do { _Pragma("unroll") for (int it = 0; it < 5; ++it) { const int c_ = tid + 512 * it, kj_ = c_ >> 4, ch_ = c_ & 15, kp_ = s0 - 128 + kj_; \
            kr[it] = (u32x4){0u, 0u, 0u, 0u}; vr[it] = kr[it]; \
            if (kp_ >= 0) { const size_t g_ = (size_t)(b * 2048 + kp_) * KVW + 128 * (ps_) + ch_ * 8; kr[it] = *(const u32x4*)(Kb + g_); vr[it] = *(const u32x4*)(Vb + g_); } } } while (0)
#define ATT_STOREKV() do { _Pragma("unroll") for (int it = 0; it < 5; ++it) { const int c_ = tid + 512 * it, kj_ = c_ >> 4, ch_ = c_ & 15; \
            const int off_ = ((ch_ >> 3) * 160 + kj_) * KROW + (ch_ & 7) * 16; *(LAS u32x4*)(lds + L_K + off_) = kr[it]; *(LAS u32x4*)(lds + L_V + off_) = vr[it]; } } while (0)
        bf16x8 qf[2][2];
        ATT_LOADKV(0);
        load_q<2>(qf, Q + (size_t)row0 * AW + wave * 64, 32, lane);
        const float sink0 = p.sinks[wave], sink1 = p.sinks[8 + wave];
        ATT_STOREKV();
        __syncthreads();
        ATT_LOADKV(1);
        attn_core<2>(lds + L_K + (wave >> 2) * KVH_BYTES, lds + L_V + (wave >> 2) * KVH_BYTES, qf, sink0, kmin, o[0], lane);
        load_q<2>(qf, Q + (size_t)row0 * AW + (8 + wave) * 64, 32, lane);
        __syncthreads();
        ATT_STOREKV();
        __syncthreads();
        attn_core<2>(lds + L_K + (wave >> 2) * KVH_BYTES, lds + L_V + (wave >> 2) * KVH_BYTES, qf, sink1, kmin, o[1], lane);
#undef ATT_LOADKV
#undef ATT_STOREKV
#pragma unroll
        for (int qb = 0; qb < 2; ++qb) {
            float ss = 0.f;
#pragma unroll
            for (int ps = 0; ps < 2; ++ps)
#pragma unroll
                for (int dt = 0; dt < 4; ++dt) { const f32x4 v = o[ps][qb][dt]; ss += (v[0] * v[0] + v[1] * v[1]) + (v[2] * v[2] + v[3] * v[3]); }
            ss = fq_sum(ss);
            if (fq == 0) red[(16 * qb + fr) * 8 + wave] = ss;
        }
        __syncthreads();
#pragma unroll
        for (int qb = 0; qb < 2; ++qb) {
            const LAS f32x4* rr = (const LAS f32x4*)(red + (16 * qb + fr) * 8); const f32x4 t = rr[0] + rr[1];
            const float ra = rsqrtf(((t[0] + t[1]) + (t[2] + t[3])) * (1.0f / 1024.0f) + EPS);
#pragma unroll
            for (int ps = 0; ps < 2; ++ps)
#pragma unroll
                for (int dt = 0; dt < 4; ++dt) {
                    const f32x4 v = o[ps][qb][dt] * ra; u32x2 w; w.x = pk2(v[0], v[1]); w.y = pk2(v[2], v[3]);
                    *(u32x2*)(MIX + (size_t)(row0 + 16 * qb + fr) * DM + (8 * ps + wave) * 64 + 16 * dt + 4 * fq) = w;
                }
        }
        __syncthreads();
    }
}
__device__ __forceinline__ void p2_prompt_sg(const Params& p, LAS unsigned char* lds, int unit) {
    const int tid = opaque(threadIdx.x), lane = tid & 63, wave = __builtin_amdgcn_readfirstlane(tid >> 6);
    unsigned char* ws = p.ws;
    const bf16_t* U = (const bf16_t*)(ws + OFF_U); const bf16_t* Gm = (const bf16_t*)(ws + OFF_G); bf16_t* MIX = (bf16_t*)(ws + OFF_MIX);
    const float* gss = (const float*)(ws + OFF_GSS); const bf16_t* wsg = (const bf16_t*)(ws + OFF_WSG);
    const int b = unit >> 6, s0 = (unit & 63) * 32, row0 = b * 2048 + s0;
    const int fr = lane & 15, fq = lane >> 4, tq = (lane & 15) >> 2, tp = lane & 3;
    LAS float* red = (LAS float*)(lds + L_RED2);
    LAS float* rgl = (LAS float*)(lds + L_RG2);
    {
        const int c = (s0 >> 5) & 3, crow0 = b * 2048 + (s0 & ~127), nrows = 32 * (c + 1), nk = 2 * (c + 1);
        const int sj = tid >> 5, sch = tid & 31;
        u32x4 gv[8]; f32x4 gn0, gn1;
#define SG_LOADG(ps_) do { _Pragma("unroll") for (int k = 0; k < 8; ++k) if (k < nk) gv[k] = *(const u32x4*)(Gm + (size_t)(crow0 + sj + 16 * k) * SGW + 256 * (ps_) + 8 * sch); \
            gn0 = *(const f32x4*)(p.sg_norm + 256 * (ps_) + 8 * sch); gn1 = *(const f32x4*)(p.sg_norm + 256 * (ps_) + 8 * sch + 4); } while (0)
#define SG_STOREG(buf_) do { _Pragma("unroll") for (int k = 0; k < 8; ++k) if (k < nk) { const float r_ = rgl[sj + 16 * k]; const f32x4 n0_ = gn0 * r_, n1_ = gn1 * r_; const u32x4 g_ = gv[k]; u32x4 w_; \
            w_.x = pk2(bf_lo(g_.x) * n0_[0], bf_hi(g_.x) * n0_[1]); w_.y = pk2(bf_lo(g_.y) * n0_[2], bf_hi(g_.y) * n0_[3]); \
            w_.z = pk2(bf_lo(g_.z) * n1_[0], bf_hi(g_.z) * n1_[1]); w_.w = pk2(bf_lo(g_.w) * n1_[2], bf_hi(g_.w) * n1_[3]); \
            *(LAS u32x4*)(lds + (buf_) * GBUF + (sj + 16 * k) * GROW + sch * 16) = w_; } } while (0)
        SG_LOADG(0);
        if (tid < nrows) rgl[tid] = rowscale16(gss + (size_t)(crow0 + tid) * 16);
        __syncthreads();
        SG_STOREG(0);
        __syncthreads();
        f32x4 sg[4][2][2];
#pragma unroll
        for (int ps = 0; ps < 4; ++ps) {
            const int hl = wave >> 2, head = 2 * ps + hl, dq = wave & 3;
            if (ps < 3) SG_LOADG(ps + 1);
            bf16x8 wf[4][2]; u32x2 uv[2][2]; float bias[2];
#pragma unroll
            for (int J = 0; J < 4; ++J)
                if (J <= c) {
#pragma unroll
                    for (int ib = 0; ib < 2; ++ib) wf[J][ib] = *(const bf16x8*)(wsg + ((size_t)(head * 128 + 32 * c + 16 * ib + fr) * 128 + 32 * J + 8 * fq));
                }
#pragma unroll
            for (int ib = 0; ib < 2; ++ib) {
                bias[ib] = p.sg_b[head * 128 + 32 * c + 16 * ib + fr];
#pragma unroll
                for (int dt = 0; dt < 2; ++dt) uv[ib][dt] = *(const u32x2*)(U + (size_t)(row0 + 16 * ib + fr) * SGW + head * 128 + 32 * dq + 16 * dt + 4 * fq);
            }
            f32x4 a[2][2];
#pragma unroll
            for (int ib = 0; ib < 2; ++ib)
#pragma unroll
                for (int dt = 0; dt < 2; ++dt) a[ib][dt] = (f32x4){0.f, 0.f, 0.f, 0.f};
#pragma unroll
            for (int J = 0; J < 4; ++J)
                if (J <= c) {
                    const LAS unsigned char* gp = lds + (ps & 1) * GBUF + (32 * J + 8 * fq + tq) * GROW + (128 * hl + 32 * dq + 4 * tp) * 2;
#pragma unroll
                    for (int dt = 0; dt < 2; ++dt) {
                        const s16x4 lo = ldtr(gp + 32 * dt), hi = ldtr(gp + 4 * GROW + 32 * dt);
                        const bf16x8 gf = __builtin_shufflevector(lo, hi, 0, 1, 2, 3, 4, 5, 6, 7);
#pragma unroll
                        for (int ib = 0; ib < 2; ++ib) a[ib][dt] = __builtin_amdgcn_mfma_f32_16x16x32_bf16(gf, wf[J][ib], a[ib][dt], 0, 0, 0);
                    }
                }
#pragma unroll
            for (int ib = 0; ib < 2; ++ib)
#pragma unroll
                for (int dt = 0; dt < 2; ++dt) {
                    f32x4 v = a[ib][dt] + bias[ib];
                    v[0] *= bf_lo(uv[ib][dt].x); v[1] *= bf_hi(uv[ib][dt].x); v[2] *= bf_lo(uv[ib][dt].y); v[3] *= bf_hi(uv[ib][dt].y);
                    sg[ps][ib][dt] = v;
                }
            if (ps < 3) SG_STOREG((ps + 1) & 1);
            __syncthreads();
        }
#undef SG_LOADG
#undef SG_STOREG
#pragma unroll
        for (int ib = 0; ib < 2; ++ib) {
            float ss = 0.f;
#pragma unroll
            for (int ps = 0; ps < 4; ++ps)
#pragma unroll
                for (int dt = 0; dt < 2; ++dt) { const f32x4 v = sg[ps][ib][dt]; ss += (v[0] * v[0] + v[1] * v[1]) + (v[2] * v[2] + v[3] * v[3]); }
            ss = fq_sum(ss);
            if (fq == 0) red[(16 * ib + fr) * 8 + wave] = ss;
        }
        __syncthreads();
#pragma unroll
        for (int ib = 0; ib < 2; ++ib) {
            const LAS f32x4* rr = (const LAS f32x4*)(red + (16 * ib + fr) * 8); const f32x4 t = rr[0] + rr[1];
            const float rs = rsqrtf(((t[0] + t[1]) + (t[2] + t[3])) * (1.0f / 1024.0f) + EPS);
#pragma unroll
            for (int ps = 0; ps < 4; ++ps)
#pragma unroll
                for (int dt = 0; dt < 2; ++dt) {
                    const f32x4 v = sg[ps][ib][dt] * rs; u32x2 w; w.x = pk2(v[0], v[1]); w.y = pk2(v[2], v[3]);
                    *(u32x2*)(MIX + (size_t)(row0 + 16 * ib + fr) * DM + AW + (2 * ps + (wave >> 2)) * 128 + 32 * (wave & 3) + 16 * dt + 4 * fq) = w;
                }
        }
        __syncthreads();
    }
}

__device__ __forceinline__ void p2_sample_unit(const Params& p, LAS unsigned char* lds, int b) {
    const int tid = opaque(threadIdx.x), lane = tid & 63, wave = __builtin_amdgcn_readfirstlane(tid >> 6);
    unsigned char* ws = p.ws;
    const bf16_t* Q = (const bf16_t*)(ws + OFF_Q); const bf16_t* Kb = (const bf16_t*)(ws + OFF_KB); const bf16_t* Vb = (const bf16_t*)(ws + OFF_VB);
    const bf16_t* U = (const bf16_t*)(ws + OFF_U); const bf16_t* Gm = (const bf16_t*)(ws + OFF_G); bf16_t* MIX = (bf16_t*)(ws + OFF_MIX);
    const float* gss = (const float*)(ws + OFF_GSS);
    const int row0 = MP + 8 * b, fr = lane & 15, fq = lane >> 4;
    LAS float* red = (LAS float*)(lds + L_RED);
    LAS float* rgl = (LAS float*)(lds + L_RG);
    {
        f32x4 o[2][1][4];
#pragma unroll
        for (int ps = 0; ps < 2; ++ps) {
            bf16x8 qf1[1][2];
            load_q<1>(qf1, Q + (size_t)row0 * AW + (8 * ps + wave) * 64, 8, lane);
            const float sinkv = p.sinks[8 * ps + wave];
            {
                const int kr = tid >> 4, ch = tid & 15;
                f32x4 ck[4][2], cv[4][2]; u32x4 nk = (u32x4){0u, 0u, 0u, 0u}, nv = nk;
#pragma unroll
                for (int it = 0; it < 4; ++it) {
                    const size_t g = ((size_t)(b * 128 + kr + 32 * it)) * KVW + 128 * ps + ch * 8;
                    ck[it][0] = *(const f32x4*)(p.cache_k + g); ck[it][1] = *(const f32x4*)(p.cache_k + g + 4); cv[it][0] = *(const f32x4*)(p.cache_v + g); cv[it][1] = *(const f32x4*)(p.cache_v + g + 4);
                }
                if (kr < 8) { const size_t g = (size_t)(row0 + kr) * KVW + 128 * ps + ch * 8; nk = *(const u32x4*)(Kb + g); nv = *(const u32x4*)(Vb + g); }
#pragma unroll
                for (int it = 0; it < 4; ++it) {
                    const int kj = kr + 32 * it;
                    const f32x4 k0 = ck[it][0], k1 = ck[it][1], v0 = cv[it][0], v1 = cv[it][1];
                    u32x4 kv, vv;
                    kv.x = pk2(k0[0], k0[1]); kv.y = pk2(k0[2], k0[3]); kv.z = pk2(k1[0], k1[1]); kv.w = pk2(k1[2], k1[3]);
                    vv.x = pk2(v0[0], v0[1]); vv.y = pk2(v0[2], v0[3]); vv.z = pk2(v1[0], v1[1]); vv.w = pk2(v1[2], v1[3]);
                    if (kj >= 8) {
                        const size_t d = ((size_t)(b * 128 + kj - 8)) * KVW + 128 * ps + ch * 8;
                        float* kd = p.out + OUT_KWS + d; float* vd = p.out + OUT_VWS + d;
                        *(f32x4*)kd = k0; *(f32x4*)(kd + 4) = k1; *(f32x4*)vd = v0; *(f32x4*)(vd + 4) = v1;
                    }
                    const int off = ((ch >> 3) * 160 + kj) * KROW + (ch & 7) * 16;
                    *(LAS u32x4*)(lds + L_K + off) = kv; *(LAS u32x4*)(lds + L_V + off) = vv;
                }
                const int off4 = ((ch >> 3) * 160 + 128 + kr) * KROW + (ch & 7) * 16;
                *(LAS u32x4*)(lds + L_K + off4) = nk; *(LAS u32x4*)(lds + L_V + off4) = nv;
            }
            __syncthreads();
            const int head = 8 * ps + wave, kvl = wave >> 2;
            attn_core<1>(lds + L_K + kvl * KVH_BYTES, lds + L_V + kvl * KVH_BYTES, qf1, sinkv, 0, o[ps], lane);
            __syncthreads();
        }
        float ss = 0.f;
#pragma unroll
        for (int ps = 0; ps < 2; ++ps)
#pragma unroll
            for (int dt = 0; dt < 4; ++dt) { const f32x4 v = o[ps][0][dt]; ss += (v[0] * v[0] + v[1] * v[1]) + (v[2] * v[2] + v[3] * v[3]); }
        ss = fq_sum(ss);
        if (fq == 0) red[fr * 8 + wave] = ss;
        __syncthreads();
        {
            const LAS f32x4* rr = (const LAS f32x4*)(red + fr * 8); const f32x4 t = rr[0] + rr[1];
            const float ra = rsqrtf(((t[0] + t[1]) + (t[2] + t[3])) * (1.0f / 1024.0f) + EPS);
            if (fr < 8) {
#pragma unroll
                for (int ps = 0; ps < 2; ++ps)
#pragma unroll
                    for (int dt = 0; dt < 4; ++dt) {
                        const f32x4 v = o[ps][0][dt] * ra; u32x2 w; w.x = pk2(v[0], v[1]); w.y = pk2(v[2], v[3]);
                        *(u32x2*)(MIX + (size_t)(row0 + fr) * DM + (8 * ps + wave) * 64 + 16 * dt + 4 * fq) = w;
                    }
            }
        }
        __syncthreads();
    }
}
__device__ __forceinline__ void p2_sample_sg(const Params& p, LAS unsigned char* lds, int b) {
    const int tid = opaque(threadIdx.x), lane = tid & 63, wave = __builtin_amdgcn_readfirstlane(tid >> 6);
    unsigned char* ws = p.ws;
    const bf16_t* U = (const bf16_t*)(ws + OFF_U); const bf16_t* Gm = (const bf16_t*)(ws + OFF_G); bf16_t* MIX = (bf16_t*)(ws + OFF_MIX);
    const float* gss = (const float*)(ws + OFF_GSS);
    const int row0 = MP + 8 * b;
    LAS float* red = (LAS float*)(lds + L_RED);
    LAS float* rgl = (LAS float*)(lds + L_RG);
    {
        if (tid < 8) rgl[tid] = rowscale16(gss + (size_t)(row0 + tid) * 16);
        __syncthreads();
        const int col = 2 * tid, h = col >> 7;
        const float n0 = p.sg_norm[col], n1 = p.sg_norm[col + 1];
        float g0[8], g1[8];
#pragma unroll
        for (int j = 0; j < 8; ++j) {
            const unsigned gv = *(const unsigned*)(Gm + (size_t)(row0 + j) * SGW + col); const float r = rgl[j];
            g0[j] = bf_lo(gv) * r * n0; g1[j] = bf_hi(gv) * r * n1;
            float* sv = p.out + OUT_SGV + (size_t)(b * 8 + j) * SGW + col; sv[0] = g0[j]; sv[1] = g1[j];
        }
        float o0[8], o1[8];
#pragma unroll
        for (int i = 0; i < 8; ++i) {
            float m0 = p.sg_b[h * 128 + i], m1 = m0;
#pragma unroll
            for (int j = 0; j <= i; ++j) { const float w = p.sg_w[(size_t)(h * 128 + i) * 128 + j]; m0 += w * g0[j]; m1 += w * g1[j]; }
            const unsigned uv = *(const unsigned*)(U + (size_t)(row0 + i) * SGW + col);
            o0[i] = m0 * bf_lo(uv); o1[i] = m1 * bf_hi(uv);
            const float ss = wave_sum(o0[i] * o0[i] + o1[i] * o1[i]);
            if (lane == 0) red[i * 8 + wave] = ss;
        }
        __syncthreads();
#pragma unroll
        for (int i = 0; i < 8; ++i) {
            const LAS f32x4* rr = (const LAS f32x4*)(red + i * 8); const f32x4 t = rr[0] + rr[1];
            const float rs = rsqrtf(((t[0] + t[1]) + (t[2] + t[3])) * (1.0f / 1024.0f) + EPS);
            *(unsigned*)(MIX + (size_t)(row0 + i) * DM + AW + col) = pk2(o0[i] * rs, o1[i] * rs);
        }
        __syncthreads();
    }
}


typedef unsigned gu32;
#define XB_TMO      128
#define XB_XCNT(j)  (256  + 64 * (j))
#define XB_XSUB(j)  (1280 + 64 * (j))
#define XB_XGEN(j)  (2304 + 64 * (j))
#define XB_TOP      3328
#define XB_TOPGEN   3392
#define XCD_BAR_WORDS 3456
#define XB_SPIN_CAP (1u << 18)
__device__ __forceinline__ unsigned xb_ld(unsigned* p)              { return __hip_atomic_load(p, __ATOMIC_RELAXED, __HIP_MEMORY_SCOPE_AGENT); }
__device__ __forceinline__ unsigned xb_add(unsigned* p, unsigned v) { return __hip_atomic_fetch_add(p, v, __ATOMIC_RELAXED, __HIP_MEMORY_SCOPE_AGENT); }
__device__ __forceinline__ unsigned xb_xcc_id() { return (unsigned)__builtin_amdgcn_s_getreg((3 << 11) | 20) & 0xFu; }
#define XB_SPIN(cond, bar) do { unsigned _sp = 0; while (cond) { __builtin_amdgcn_s_sleep(1); \
    if ((++_sp & 255u) == 0u) { if (xb_ld(&(bar)[XB_TMO])) break; if (_sp > XB_SPIN_CAP) { atomicAdd(&(bar)[XB_TMO], 1u); break; } } } } while (0)
struct XcdBarrier { unsigned* bar; unsigned x; volatile LAS unsigned* st; };
__device__ __forceinline__ XcdBarrier xcd_barrier_post(unsigned* bar, volatile LAS unsigned* st) {
    XcdBarrier b; b.bar = bar; b.x = xb_xcc_id(); b.st = st;
    if (threadIdx.x == 0) (void)xb_add(&bar[XB_XCNT(b.x)], 1u);
    return b;
}
__device__ __forceinline__ void xcd_barrier_complete(unsigned* bar, unsigned x, unsigned& nloc, unsigned& nx) {
    const unsigned G = gridDim.x * gridDim.y * gridDim.z;
    unsigned sum, cnt, mine, sp = 0u;
    for (;;) {
        sum = 0u; cnt = 0u; mine = 0u;
#pragma unroll
        for (unsigned j = 0; j < 16; ++j) { const unsigned c = xb_ld(&bar[XB_XCNT(j)]); sum += c; cnt += (c > 0u) ? 1u : 0u; mine = (j == x) ? c : mine; }
        if (sum == G) break;
        __builtin_amdgcn_s_sleep(1);
        if ((++sp & 255u) == 0u) { if (xb_ld(&bar[XB_TMO])) break; if (sp > XB_SPIN_CAP) { atomicAdd(&bar[XB_TMO], 1u); break; } }
    }
    nloc = mine > 0u ? mine : 1u; nx = cnt > 0u ? cnt : 1u;
}
__device__ __forceinline__ void xcd_barrier(const XcdBarrier& b) {
    asm volatile("s_waitcnt vmcnt(0)" ::: "memory");
    __syncthreads();
    if (threadIdx.x == 0) {
        unsigned* bar = b.bar;
        __builtin_amdgcn_s_waitcnt(0);
        unsigned nloc = b.st[0], nx = b.st[1];
        if (nloc == 0u) { xcd_barrier_complete(bar, b.x, nloc, nx); b.st[0] = nloc; b.st[1] = nx; }
        const unsigned old = xb_add(&bar[XB_XSUB(b.x)], 1u);
        const unsigned gen = old / nloc;
        if (old + 1u == (gen + 1u) * nloc) {
            __builtin_amdgcn_fence(__ATOMIC_RELEASE, "agent");
            asm volatile("s_waitcnt vmcnt(0)" ::: "memory");
            const unsigned og = xb_add(&bar[XB_TOP], 1u);
            const unsigned tg = og / nx;
            if (og + 1u == (tg + 1u) * nx) xb_add(&bar[XB_TOPGEN], 1u);
            else XB_SPIN(xb_ld(&bar[XB_TOPGEN]) == tg, bar);
            __builtin_amdgcn_fence(__ATOMIC_ACQUIRE, "agent");
            xb_add(&bar[XB_XGEN(b.x)], 1u);
            asm volatile("s_waitcnt vmcnt(0)" ::: "memory");
        } else {
            XB_SPIN(xb_ld(&bar[XB_XGEN(b.x)]) == gen, bar);
            __builtin_amdgcn_fence(__ATOMIC_ACQUIRE, "agent");
            asm volatile("s_waitcnt vmcnt(0)" ::: "memory");
        }
    }
    __syncthreads();
}

#ifndef P3_MAXSF
#define P3_MAXSF 8
#endif
#ifndef P4_MAXSF
#define P4_MAXSF 4
#endif
#ifndef REP_P0
#define REP_P0 0
#endif
#ifndef REP_P2
#define REP_P2 0
#endif
#ifndef REP_P1
#define REP_P1 0
#endif
#ifndef REP_P3
#define REP_P3 0
#endif
#ifndef REP_P4
#define REP_P4 0
#endif
#ifndef EXTRA_SYNCS
#define EXTRA_SYNCS 0
#endif
#ifndef USE_CG_SYNC
#define USE_CG_SYNC 0
#endif
constexpr int LDS_BYTES = 147456;
__global__ void __launch_bounds__(512, 2) hymba_fwd(Params p) {
    extern __shared__ __attribute__((aligned(16))) unsigned char lds_raw[];
    LAS unsigned char* lds = (LAS unsigned char*)lds_raw;
    cg::grid_group grid = cg::this_grid();
    const int G = gridDim.x;
    unsigned char* ws = p.ws;
    volatile LAS unsigned* bst = (volatile LAS unsigned*)(lds + 147200);
    if (threadIdx.x < 2) bst[threadIdx.x] = 0u;
    __syncthreads();
    const XcdBarrier xbar = xcd_barrier_post((unsigned*)(ws + OFF_BAR), bst);
    if (p.out == nullptr) grid.sync();
#if USE_CG_SYNC
#define SEAM() grid.sync()
#else
#define SEAM() xcd_barrier(xbar)
#endif

#pragma unroll 1
    for (int rep = 0; rep <= REP_P0; ++rep) {
    p0_prologue(p, lds);
    SEAM();
    }
#pragma unroll 1
    for (int rep = 0; rep < EXTRA_SYNCS; ++rep) SEAM();
#pragma unroll 1
    for (int rep1 = 0; rep1 <= REP_P1; ++rep1) {
        pg8::Gemm g{(const bf16_t*)(ws + OFF_XN), (const bf16_t*)(ws + OFF_WIN), MT, INW, DM}; pg8::TailSplitOrder S; S.init(MT, INW, DM, G, (int)blockIdx.x);
        EpiProj E{(bf16_t*)(ws + OFF_Q), (bf16_t*)(ws + OFF_KB), (bf16_t*)(ws + OFF_VB), (bf16_t*)(ws + OFF_U), (bf16_t*)(ws + OFF_G), (float*)(ws + OFF_GSS),
                  (const float*)(ws + OFF_ROPE), p.q_norm, p.k_norm, p.out};
        const pg8::SplitCtx sc{(float*)(ws + OFF_WO), 1 << 30, nullptr, (unsigned*)(ws + OFF_BAR + 16384)};
        pg8::gemm_phase(lds, g, S, E, sc);
    SEAM();
    }
#pragma unroll 1
    for (int rep = 0; rep <= REP_P2; ++rep) {
        for (int u = blockIdx.x; u < 256; u += G) { p2_prompt_att(p, lds, u); p2_prompt_sg(p, lds, u); }
        for (int i = blockIdx.x; i < 256; i += G) { if (i < 128) p2_sample_unit(p, lds, i); else p2_sample_sg(p, lds, i - 128); }
        SEAM();
    }
#pragma unroll 1
    for (int rep3 = 0; rep3 <= REP_P3; ++rep3) {
        pg8::Gemm g{(const bf16_t*)(ws + OFF_MIX), (const bf16_t*)(ws + OFF_WO), MT, DM, DM}; pg8::TailSplitOrder S; S.init(MT, DM, DM, G, (int)blockIdx.x, P3_MAXSF);
        EpiWo E{p, (bf16_t*)(ws + OFF_HB), (float*)(ws + OFF_HSS)};
        const pg8::SplitCtx sc{(float*)(ws + OFF_XN), 1 << 30, nullptr, (unsigned*)(ws + OFF_BAR + 16384) + 1024};
        pg8::gemm_phase(lds, g, S, E, sc);
    SEAM();
    }
#pragma unroll 1
    for (int rep4 = 0; rep4 <= REP_P4; ++rep4) {
        pg8::Gemm g{(const bf16_t*)(ws + OFF_HB), (const bf16_t*)(ws + OFF_WGU), MT, 2 * FF, DM}; pg8::TailSplitOrder S; S.init(MT, 2 * FF, DM, G, (int)blockIdx.x, P4_MAXSF);
        EpiGU E{(const float*)(ws + OFF_HSS), (bf16_t*)(ws + OFF_ACT)};
        const pg8::SplitCtx sc{(float*)(ws + OFF_WIN), (int)((OFF_WGU - OFF_WIN) / 262144), (float*)(ws + OFF_MIX), (unsigned*)(ws + OFF_BAR + 16384) + 2048};
        pg8::gemm_phase(lds, g, S, E, sc);
    SEAM();
    }
    {
        pg8::Gemm g{(const bf16_t*)(ws + OFF_ACT), (const bf16_t*)(ws + OFF_WDN), MT, DM, FF}; pg8::TailSplitOrder S; S.init(MT, DM, FF, G, (int)blockIdx.x);
        EpiDown E{p.out, (const bf16_t*)(ws + OFF_HB)};
        const pg8::SplitCtx sc{(float*)(ws + OFF_WIN), 1 << 30, nullptr, (unsigned*)(ws + OFF_BAR + 16384) + 3072};
        pg8::gemm_phase(lds, g, S, E, sc);
    }
}

extern "C" void kernel_launch(void* const* d_in, const int* in_sizes, int n_in, void* d_out, int out_size, void* d_ws, size_t ws_size, hipStream_t stream) {
    static int grid = 0;
    if (grid == 0) {
        if (n_in != 19 || ws_size < WS_END) { fprintf(stderr, "kernel_launch: need 19 inputs and >= %zu bytes of workspace (got %d, %zu)\n", (size_t)WS_END, n_in, ws_size); grid = -1; return; }
        int dev = 0, cus = 0, per_cu = 0;
        hipGetDevice(&dev);
        hipDeviceGetAttribute(&cus, hipDeviceAttributeMultiprocessorCount, dev);
        if (hipFuncSetAttribute((const void*)hymba_fwd, hipFuncAttributeMaxDynamicSharedMemorySize, LDS_BYTES) != hipSuccess) { fprintf(stderr, "kernel_launch: hipFuncSetAttribute failed\n"); grid = -1; return; }
        if (hipOccupancyMaxActiveBlocksPerMultiprocessor(&per_cu, (const void*)hymba_fwd, 512, LDS_BYTES) != hipSuccess || per_cu < 1) { fprintf(stderr, "kernel_launch: occupancy query failed (%d)\n", per_cu); per_cu = 1; }
        (void)hipGetLastError();
        grid = cus * (per_cu > 1 ? 1 : per_cu);
    }
    if (grid < 0) return;
    if (hipMemsetAsync((char*)d_ws + OFF_BAR, 0, BAR_BYTES, stream) != hipSuccess) { fprintf(stderr, "kernel_launch: memset failed\n"); return; }
    Params p{};
    const float** f = (const float**)&p;
    for (int i = 0; i < 19; ++i) f[i] = (const float*)d_in[i];
    p.out = (float*)d_out; p.ws = (unsigned char*)d_ws;
    void* args[] = {&p};
    hipError_t e = hipLaunchCooperativeKernel((const void*)hymba_fwd, dim3(grid), dim3(512), args, LDS_BYTES, stream);
    if (e != hipSuccess) fprintf(stderr, "cooperative launch failed: %s (grid %d)\n", hipGetErrorString(e), grid);
}
```

```cpp
#include <hip/hip_runtime.h>
#include <hip/hip_cooperative_groups.h>
#include <cstdio>
#include <cstdint>
namespace cg = cooperative_groups;

#define LAS __attribute__((address_space(3)))
typedef unsigned short bf16_t;
typedef short bf16x8 __attribute__((ext_vector_type(8)));
typedef short s16x4 __attribute__((ext_vector_type(4)));
typedef float f32x4 __attribute__((ext_vector_type(4)));
typedef unsigned u32x4 __attribute__((ext_vector_type(4)));
typedef unsigned u32x2 __attribute__((ext_vector_type(2)));

constexpr int DM = 2048, MP = 8192, MS = 1024, MT = MP + MS;
constexpr int INW = 3584, FF = 5632, AW = 1024, SGW = 1024, KVW = 256;
constexpr float EPS = 1e-6f;
constexpr int NROPE = 2056;

constexpr size_t OFF_WIN = 0;
constexpr size_t OFF_WO = OFF_WIN + (size_t)INW * DM * 2;
constexpr size_t OFF_WGU = OFF_WO + (size_t)DM * DM * 2;
constexpr size_t OFF_WDN = OFF_WGU + (size_t)2 * FF * DM * 2;
constexpr size_t OFF_HB = OFF_WDN + (size_t)DM * FF * 2;
constexpr size_t OFF_ROPE = OFF_HB + (size_t)MT * DM * 2;
constexpr size_t OFF_WSG = OFF_ROPE + (size_t)NROPE * 64 * 4;
constexpr size_t OFF_GSS = OFF_WSG + (size_t)8 * 128 * 128 * 2;
constexpr size_t OFF_HSS = OFF_GSS + (size_t)MT * 16 * 4;
constexpr size_t OFF_BAR = OFF_HSS + (size_t)MT * 32 * 4;
constexpr size_t BAR_BYTES = 32768;
constexpr size_t OFF_ACT = OFF_BAR + BAR_BYTES;
constexpr size_t OFF_XN = OFF_ACT;
constexpr size_t OFF_Q = OFF_XN + (size_t)MT * DM * 2;
constexpr size_t OFF_KB = OFF_Q + (size_t)MT * AW * 2;
constexpr size_t OFF_VB = OFF_KB + (size_t)MT * KVW * 2;
constexpr size_t OFF_U = OFF_VB + (size_t)MT * KVW * 2;
constexpr size_t OFF_G = OFF_U + (size_t)MT * SGW * 2;
constexpr size_t OFF_MIX = OFF_G + (size_t)MT * SGW * 2;
constexpr size_t WS_END = OFF_MIX + (size_t)152 * 262144;
static_assert(OFF_ACT + (size_t)MT * FF * 2 <= OFF_MIX, "ACT overlay fits");
static_assert((size_t)256 * 262144 <= OFF_WDN && (size_t)256 * 262144 <= OFF_MIX - OFF_XN, "partial-tile slots overlay only dead buffers");
static_assert(OFF_ACT % 256 == 0 && OFF_ROPE % 256 == 0 && OFF_WSG % 256 == 0, "alignment");

constexpr size_t OUT_Y = 0;
constexpr size_t OUT_KWP = (size_t)MT * DM;
constexpr size_t OUT_VWP = OUT_KWP + 4 * 128 * 256;
constexpr size_t OUT_KWS = OUT_VWP + 4 * 128 * 256;
constexpr size_t OUT_VWS = OUT_KWS + (size_t)128 * 128 * 256;
constexpr size_t OUT_SGV = OUT_VWS + (size_t)128 * 128 * 256;

struct Params {
    const float *x_prompt, *x_sample, *cache_k, *cache_v, *attn_norm, *w_in, *q_norm, *k_norm, *sinks, *sg_norm, *sg_w, *sg_b,
        *attn_out_norm, *sg_out_norm, *w_o, *ffn_norm, *w_gate, *w_up, *w_down;
    float* out; unsigned char* ws;
};

__device__ const double ROPE_INV[32] = {1.0, 0.7498942093324559, 0.5623413251903491, 0.4216965034285822, 0.31622776601683794, 0.23713737056616552, 0.1778279410038923, 0.1333521432163324, 0.1, 0.07498942093324558, 0.05623413251903491, 0.042169650342858224, 0.03162277660168379, 0.023713737056616554, 0.01778279410038923, 0.01333521432163324, 0.01, 0.007498942093324558, 0.005623413251903491, 0.004216965034285823, 0.0031622776601683794, 0.0023713737056616554, 0.0017782794100389228, 0.001333521432163324, 0.001, 0.0007498942093324559, 0.0005623413251903491, 0.00042169650342858224, 0.00031622776601683794, 0.00023713737056616554, 0.00017782794100389227, 0.0001333521432163324};

__device__ __forceinline__ unsigned pk2(float lo, float hi) { unsigned r; asm volatile("v_cvt_pk_bf16_f32 %0, %1, %2" : "=v"(r) : "v"(lo), "v"(hi)); return r; }
__device__ __forceinline__ int opaque(int x) { asm volatile("" : "+v"(x)); return x; }
__device__ __forceinline__ float bf_lo(unsigned w) { return __builtin_bit_cast(float, w << 16); }
__device__ __forceinline__ float bf_hi(unsigned w) { return __builtin_bit_cast(float, w & 0xffff0000u); }
__device__ __forceinline__ float gelu_tanh(float x) {
    const float y = 1.5957691216057308f * (x + 0.044715f * x * x * x);
    return x * __builtin_amdgcn_rcpf(1.0f + __expf(-y));
}
typedef float f32x2 __attribute__((ext_vector_type(2)));
__device__ __forceinline__ f32x2 gelu2(f32x2 x) {
    const f32x2 t = ((x * x) * 0.044715f + 1.0f) * x;
    const f32x2 z = t * (-1.5957691216057308f * 1.4426950408889634f);
    f32x2 e; e.x = __builtin_amdgcn_exp2f(z.x); e.y = __builtin_amdgcn_exp2f(z.y);
    const f32x2 d = e + 1.0f;
    f32x2 r; r.x = __builtin_amdgcn_rcpf(d.x); r.y = __builtin_amdgcn_rcpf(d.y);
    return x * r;
}
__device__ __forceinline__ f32x2 silu_mul2(f32x2 g, f32x2 u) {
    const f32x2 z = g * (-1.4426950408889634f);
    f32x2 e; e.x = __builtin_amdgcn_exp2f(z.x); e.y = __builtin_amdgcn_exp2f(z.y);
    const f32x2 d = e + 1.0f;
    f32x2 r; r.x = __builtin_amdgcn_rcpf(d.x); r.y = __builtin_amdgcn_rcpf(d.y);
    return (g * r) * u;
}
__device__ __forceinline__ float silu(float x) { return x * __builtin_amdgcn_rcpf(1.0f + __expf(-x)); }
__device__ __forceinline__ float wave_sum(float v) {
#pragma unroll
    for (int o = 1; o < 64; o <<= 1) v += __shfl_xor(v, o);
    return v;
}
__device__ __forceinline__ float fq_sum(float v) { v += __shfl_xor(v, 16); v += __shfl_xor(v, 32); return v; }
__device__ __forceinline__ float fq_max(float v) { v = fmaxf(v, __shfl_xor(v, 16)); v = fmaxf(v, __shfl_xor(v, 32)); return v; }
__device__ __forceinline__ const float* xrow(const Params& p, int row) { return row < MP ? p.x_prompt + (size_t)row * DM : p.x_sample + (size_t)(row - MP) * DM; }

namespace pg8 {
constexpr int BM = 256, BK = 64, HALF = 128, HTB = HALF * BK * 2, STAGE_BYTES = 8 * HTB, NXCD = 8, WGM = 8;
__host__ __device__ __forceinline__ int lds_byte(int r, int c) { const int st = (r >> 4) * 2 + (c >> 5), rr = r & 15, cc = c & 31, ob = rr * 64 + cc * 2; return st * 1024 + (ob ^ (((ob >> 9) & 1) << 5)); }
__host__ __device__ __forceinline__ void stage_rc(int b, int& R, int& C) { const int st = b / 1024, sb = b % 1024, swz = sb ^ (((sb >> 9) & 1) << 5); R = (st >> 1) * 16 + swz / 64; C = (st & 1) * 32 + (swz % 64) / 2; }
struct Unit { int pm, pn, kt0, nkt, sq, sj, sf; };
struct Gemm { const bf16_t* A; const bf16_t* Bt; int M, N, K; };
struct TailSplitOrder {
    int nM, nN, nwg, G, c, ntk, nfull, rem, sf;
    __device__ void init(int M, int N, int K, int G_, int c_, int maxsf = 8) {
        nM = M / BM; nN = N / BM; nwg = nM * nN; G = G_; c = c_; ntk = K / BK; nfull = nwg / G; rem = nwg % G;
        sf = rem ? G / rem : 1; if (sf > ntk / 2) sf = ntk / 2; if (sf > maxsf) sf = maxsf; if (sf < 2) sf = 1;
    }
    __device__ void tile(int L, Unit& u) const {
        int wgid = L; { const int q = nwg / NXCD, r = nwg % NXCD, xcd = wgid % NXCD, off = wgid / NXCD; wgid = (xcd < r ? xcd * (q + 1) : r * (q + 1) + (xcd - r) * q) + off; }
        const int nig = WGM * nN, gid = wgid / nig, fm = gid * WGM, gsz = (nM - fm) < WGM ? (nM - fm) : WGM;
        u.pm = fm + ((wgid % nig) % gsz); u.pn = (wgid % nig) / gsz;
    }
    __device__ bool next(int i, Unit& u) const {
        u.kt0 = 0; u.nkt = ntk; u.sq = 0; u.sj = 0; u.sf = 1;
        if (i < nfull) { tile(i * G + c, u); return true; }
        if (i > nfull || rem == 0) return false;
        if (sf == 1) { if (c >= rem) return false; tile(nfull * G + c, u); return true; }
        const int q = c / sf, j = c % sf; if (q >= rem) return false;
        tile(nfull * G + q, u);
        const int pp = ntk / 2, a = pp * j / sf, b = pp * (j + 1) / sf;
        u.kt0 = 2 * a; u.nkt = 2 * (b - a); u.sq = q; u.sj = j; u.sf = sf; return true;
    }
};
struct SplitCtx { float* part0; int n0; float* part1; unsigned* ctr; };
template <class Epi, class Sched>
__device__ __forceinline__ void gemm_phase(LAS unsigned char* lds, const Gemm g, const Sched& S, const Epi& E, const SplitCtx sc) {
    const int tid = opaque(threadIdx.x), wid = __builtin_amdgcn_readfirstlane(tid >> 6), lane = tid & 63, wr = wid >> 2, wc = wid & 3, fr = lane & 15, fq = lane >> 4;
    const int K = g.K;
    unsigned voffA[2];
#pragma unroll
    for (int i = 0; i < 2; ++i) { int R, C; stage_rc(tid * 16 + i * 8192, R, C); voffA[i] = (unsigned)(R * K + C) * 2u; }
    const size_t kstep = (size_t)(BK * 2);
    const size_t hstep = (size_t)HALF * K * 2;
    const size_t tstep = 2 * hstep;
    const unsigned ldsw = (unsigned)wid * 1024u;
    const int aoff = lds_byte(wr * 64 + fr, fq * 8), boff = lds_byte(wc * 32 + fr, fq * 8);
#define PG8_SA(b, h) (((b) * 2 + (h)) * HTB)
#define PG8_SB(b, h) ((4 + (b) * 2 + (h)) * HTB)
#define PG8_STAGE(bufoff, gbase) do { _Pragma("unroll") for (int _i = 0; _i < 2; ++_i) \
        __builtin_amdgcn_global_load_lds((const unsigned*)((const char*)(gbase) + voffA[_i]), (LAS unsigned*)(lds + (bufoff) + ldsw + _i * 8192), 16, 0, 0); } while (0)
#define PG8_LDA(dst, b, h) do { _Pragma("unroll") for (int m = 0; m < 4; ++m) _Pragma("unroll") for (int k = 0; k < 2; ++k) dst[m][k] = *(const LAS bf16x8*)(lds + PG8_SA(b, h) + aoff + m * 2048 + k * 1024); } while (0)
#define PG8_LDB(dst, b, h) do { _Pragma("unroll") for (int n = 0; n < 2; ++n) _Pragma("unroll") for (int k = 0; k < 2; ++k) dst[n][k] = *(const LAS bf16x8*)(lds + PG8_SB(b, h) + boff + n * 2048 + k * 1024); } while (0)
#define PG8_MMA(ai, bj, At, Bt) do { __builtin_amdgcn_s_setprio(1); _Pragma("unroll") for (int m = 0; m < 4; ++m) _Pragma("unroll") for (int n = 0; n < 2; ++n) _Pragma("unroll") for (int k = 0; k < 2; ++k) \
        acc[ai][bj][m][n] = __builtin_amdgcn_mfma_f32_16x16x32_bf16(Bt[n][k], At[m][k], acc[ai][bj][m][n], 0, 0, 0); __builtin_amdgcn_s_setprio(0); } while (0)
#define PG8_WAIT_V(n) asm volatile("s_waitcnt vmcnt(" #n ")" ::: "memory")
#define PG8_WAIT_L(n) asm volatile("s_waitcnt lgkmcnt(" #n ")" ::: "memory")
#define PG8_BAR __builtin_amdgcn_s_barrier()
#define PG8_SCHED __builtin_amdgcn_sched_barrier(0)
    Unit cur, nxt; int ui = 0;
    if (!S.next(0, cur)) return;
    f32x4 acc[2][2][4][2];
#pragma unroll
    for (int a = 0; a < 2; ++a)
#pragma unroll
        for (int b = 0; b < 2; ++b)
#pragma unroll
            for (int m = 0; m < 4; ++m)
#pragma unroll
                for (int n = 0; n < 2; ++n) acc[a][b][m][n] = (f32x4){0.f, 0.f, 0.f, 0.f};
    bf16x8 At[4][2], B0[2][2], B1[2][2];
    const char* cA = (const char*)g.A + (size_t)cur.pm * tstep + (size_t)cur.kt0 * kstep; const char* cB = (const char*)g.Bt + (size_t)cur.pn * tstep + (size_t)cur.kt0 * kstep;
    PG8_STAGE(PG8_SB(0, 0), cB); PG8_STAGE(PG8_SB(0, 1), cB + hstep); PG8_STAGE(PG8_SA(0, 0), cA); PG8_STAGE(PG8_SA(0, 1), cA + hstep);
    if (wr == 1) PG8_BAR;
    PG8_WAIT_V(2); PG8_BAR;
    PG8_STAGE(PG8_SB(1, 0), cB + kstep); PG8_STAGE(PG8_SA(1, 0), cA + kstep); PG8_STAGE(PG8_SB(1, 1), cB + hstep + kstep);
    PG8_WAIT_V(6); PG8_BAR;
    for (;;) {
        const bool has_next = S.next(ui + 1, nxt);
        const char* nA = has_next ? (const char*)g.A + (size_t)nxt.pm * tstep + (size_t)nxt.kt0 * kstep : cA; const char* nB = has_next ? (const char*)g.Bt + (size_t)nxt.pn * tstep + (size_t)nxt.kt0 * kstep : cB;
        const int nt = cur.nkt;
        for (int t = 0; t < nt; t += 2) {
            const bool last = (t == nt - 2);
            const char* a1 = cA + (size_t)(t + 1) * kstep;
            const char* a2 = last ? nA : cA + (size_t)(t + 2) * kstep; const char* b2 = last ? nB : cB + (size_t)(t + 2) * kstep;
            const char* a3 = a2 + kstep; const char* b3 = b2 + kstep;
            PG8_LDB(B0, 0, 0); PG8_LDB(B1, 0, 1); PG8_SCHED; PG8_LDA(At, 0, 0); PG8_STAGE(PG8_SA(1, 1), a1 + hstep);
            PG8_WAIT_V(8); PG8_WAIT_L(0); PG8_BAR; PG8_MMA(0, 0, At, B0); PG8_MMA(0, 1, At, B1); PG8_BAR; PG8_SCHED;
            PG8_LDA(At, 0, 1); PG8_STAGE(PG8_SB(0, 0), b2); PG8_STAGE(PG8_SB(0, 1), b2 + hstep); PG8_STAGE(PG8_SA(0, 0), a2);
            PG8_WAIT_V(8); PG8_WAIT_L(0); PG8_BAR; PG8_MMA(1, 0, At, B0); PG8_MMA(1, 1, At, B1); PG8_BAR; PG8_SCHED;
            PG8_LDB(B0, 1, 0); PG8_LDB(B1, 1, 1); PG8_SCHED; PG8_LDA(At, 1, 0); PG8_STAGE(PG8_SA(0, 1), a2 + hstep);
            PG8_WAIT_V(8); PG8_WAIT_L(0); PG8_BAR; PG8_MMA(0, 0, At, B0); PG8_MMA(0, 1, At, B1); PG8_BAR; PG8_SCHED;
            PG8_LDA(At, 1, 1); PG8_STAGE(PG8_SB(1, 0), b3); PG8_STAGE(PG8_SB(1, 1), b3 + hstep); PG8_STAGE(PG8_SA(1, 0), a3);
            PG8_WAIT_V(8); PG8_WAIT_L(0); PG8_BAR; PG8_MMA(1, 0, At, B0); PG8_MMA(1, 1, At, B1); PG8_BAR; PG8_SCHED;
        }
        if (wr == 0) PG8_BAR;
        int rg0 = 0, rg1 = 8;
        if (cur.sf > 1) {
            {
                const int si = cur.sq * cur.sf + cur.sj;
                u32x4* slot = (u32x4*)((si < sc.n0 ? sc.part0 + (size_t)si * 65536 : sc.part1 + (size_t)(si - sc.n0) * 65536)) + tid;
#pragma unroll
                for (int a = 0; a < 2; ++a)
#pragma unroll
                    for (int m = 0; m < 4; ++m)
#pragma unroll
                        for (int b = 0; b < 2; ++b) {
                            const f32x4 v0 = acc[a][b][m][0], v1 = acc[a][b][m][1];
                            u32x4 w; w.x = pk2(v0[0], v0[1]); w.y = pk2(v0[2], v0[3]); w.z = pk2(v1[0], v1[1]); w.w = pk2(v1[2], v1[3]);
                            *slot = w; slot += 512; asm volatile("" : "+v"(slot));
                        }
            }
            asm volatile("s_waitcnt vmcnt(0)" ::: "memory");
            __syncthreads();
            if (tid == 0) {
                __builtin_amdgcn_fence(__ATOMIC_RELEASE, "agent");
                asm volatile("s_waitcnt vmcnt(0)" ::: "memory");
                unsigned* cw = sc.ctr + 16 * cur.sq;
                (void)__hip_atomic_fetch_add(cw, 1u, __ATOMIC_RELAXED, __HIP_MEMORY_SCOPE_AGENT);
                unsigned sp = 0;
                while (__hip_atomic_load(cw, __ATOMIC_RELAXED, __HIP_MEMORY_SCOPE_AGENT) < (unsigned)cur.sf) { __builtin_amdgcn_s_sleep(1); if (++sp > (1u << 22)) break; }
                __builtin_amdgcn_fence(__ATOMIC_ACQUIRE, "agent");
                asm volatile("s_waitcnt vmcnt(0)" ::: "memory");
            }
            __syncthreads();
            rg0 = 8 * cur.sj / cur.sf; rg1 = 8 * (cur.sj + 1) / cur.sf;
#pragma unroll
            for (int a = 0; a < 2; ++a)
#pragma unroll
                for (int m = 0; m < 4; ++m) {
                    if (a * 4 + m < rg0 || a * 4 + m >= rg1) continue;
                    f32x4 t00 = (f32x4){0.f, 0.f, 0.f, 0.f}, t01 = t00, t10 = t00, t11 = t00;
#pragma unroll 2
                    for (int j = 0; j < cur.sf; ++j) {
                        const int si = cur.sq * cur.sf + j;
                        const u32x4* slot = (const u32x4*)((si < sc.n0 ? sc.part0 + (size_t)si * 65536 : sc.part1 + (size_t)(si - sc.n0) * 65536)) + tid + (size_t)(a * 4 + m) * 1024;
                        const u32x4 w0 = slot[0], w1 = slot[512];
                        t00 += (f32x4){bf_lo(w0.x), bf_hi(w0.x), bf_lo(w0.y), bf_hi(w0.y)}; t01 += (f32x4){bf_lo(w0.z), bf_hi(w0.z), bf_lo(w0.w), bf_hi(w0.w)};
                        t10 += (f32x4){bf_lo(w1.x), bf_hi(w1.x), bf_lo(w1.y), bf_hi(w1.y)}; t11 += (f32x4){bf_lo(w1.z), bf_hi(w1.z), bf_lo(w1.w), bf_hi(w1.w)};
                    }
                    acc[a][0][m][0] = t00; acc[a][0][m][1] = t01; acc[a][1][m][0] = t10; acc[a][1][m][1] = t11;
                }
        }
        E(acc, cur, wr, wc, fr, fq, rg0, rg1);
        if (!has_next) break;
#pragma unroll
        for (int a = 0; a < 2; ++a)
#pragma unroll
            for (int b = 0; b < 2; ++b)
#pragma unroll
                for (int m = 0; m < 4; ++m)
#pragma unroll
                    for (int n = 0; n < 2; ++n) acc[a][b][m][n] = (f32x4){0.f, 0.f, 0.f, 0.f};
        cur = nxt; cA = nA; cB = nB; ++ui;
        if (wr == 1) PG8_BAR;
    }
    PG8_WAIT_V(0);
    PG8_BAR;
#undef PG8_SA
#undef PG8_SB
#undef PG8_STAGE
#undef PG8_LDA
#undef PG8_LDB
#undef PG8_MMA
#undef PG8_WAIT_V
#undef PG8_WAIT_L
#undef PG8_BAR
#undef PG8_SCHED
}
}
using pg8::Unit;

typedef f32x4 Acc[2][2][4][2];

struct EpiProj {
    bf16_t *Q, *Kb, *Vb, *U, *G; float* gss; const float* rope; const float *qn, *kn; float* out;
    __device__ __forceinline__ void operator()(const Acc& acc, const Unit& u, int wr, int wc, int fr, int fq, int rg0, int rg1) const {
        const int pn = u.pn;
        const int rbase = u.pm * 256 + wr * 64 + fr;
        if (pn < 5) {
            const bool isq = pn < 4;
            const float* nw = (isq ? qn : kn) + 8 * fq;
            const f32x4 w00 = *(const f32x4*)(nw), w01 = *(const f32x4*)(nw + 4), w10 = *(const f32x4*)(nw + 32), w11 = *(const f32x4*)(nw + 36);
            const float osc = isq ? 0.125f : 1.0f;
#pragma unroll
            for (int ai = 0; ai < 2; ++ai)
#pragma unroll
                for (int m = 0; m < 4; ++m) {
                if (ai * 4 + m < rg0 || ai * 4 + m >= rg1) continue;
                    if (ai * 4 + m < rg0 || ai * 4 + m >= rg1) continue;
                    const int row = rbase + ai * 128 + m * 16;
                    float ss = 0.f;
#pragma unroll
                    for (int bj = 0; bj < 2; ++bj)
#pragma unroll
                        for (int n = 0; n < 2; ++n) { const f32x4 v = acc[ai][bj][m][n]; ss += (v[0] * v[0] + v[1] * v[1]) + (v[2] * v[2] + v[3] * v[3]); }
                    ss = fq_sum(ss);
                    const float r = rsqrtf(ss * (1.0f / 64.0f) + EPS);
                    const int pidx = row < MP ? (row & 2047) : 2048 + (row & 7);
                    const float* rp = rope + pidx * 64 + 8 * fq;
                    const f32x4 c0 = *(const f32x4*)(rp), c1 = *(const f32x4*)(rp + 4), s0 = *(const f32x4*)(rp + 32), s1 = *(const f32x4*)(rp + 36);
                    const f32x4 x10 = acc[ai][0][m][0] * w00 * r, x11 = acc[ai][0][m][1] * w01 * r, x20 = acc[ai][1][m][0] * w10 * r, x21 = acc[ai][1][m][1] * w11 * r;
                    const f32x4 o10 = (x10 * c0 - x20 * s0) * osc, o11 = (x11 * c1 - x21 * s1) * osc, o20 = (x20 * c0 + x10 * s0) * osc, o21 = (x21 * c1 + x11 * s1) * osc;
                    u32x4 lo, hi;
                    lo.x = pk2(o10[0], o10[1]); lo.y = pk2(o10[2], o10[3]); lo.z = pk2(o11[0], o11[1]); lo.w = pk2(o11[2], o11[3]);
                    hi.x = pk2(o20[0], o20[1]); hi.y = pk2(o20[2], o20[3]); hi.z = pk2(o21[0], o21[1]); hi.w = pk2(o21[2], o21[3]);
                    if (isq) {
                        bf16_t* d = Q + (size_t)row * AW + (4 * pn + wc) * 64 + 8 * fq;
                        *(u32x4*)d = lo; *(u32x4*)(d + 32) = hi;
                    } else {
                        bf16_t* d = Kb + (size_t)row * KVW + wc * 64 + 8 * fq;
                        *(u32x4*)d = lo; *(u32x4*)(d + 32) = hi;
                        float* wdst = nullptr;
                        if (row >= MP) { const int rr = row - MP; wdst = out + OUT_KWS + ((size_t)((rr >> 3) * 128 + 120 + (rr & 7)) * 4 + wc) * 64 + 8 * fq; }
                        else if ((row & 2047) >= 1920) wdst = out + OUT_KWP + ((size_t)((row >> 11) * 128 + (row & 2047) - 1920) * 4 + wc) * 64 + 8 * fq;
                        if (wdst) { *(f32x4*)wdst = o10; *(f32x4*)(wdst + 4) = o11; *(f32x4*)(wdst + 32) = o20; *(f32x4*)(wdst + 36) = o21; }
                    }
                }
        } else if (pn == 5) {
#pragma unroll
            for (int ai = 0; ai < 2; ++ai)
#pragma unroll
                for (int m = 0; m < 4; ++m) {
                if (ai * 4 + m < rg0 || ai * 4 + m >= rg1) continue;
                    if (ai * 4 + m < rg0 || ai * 4 + m >= rg1) continue;
                    const int row = rbase + ai * 128 + m * 16;
                    float* wdst = nullptr;
                    if (row >= MP) { const int rr = row - MP; wdst = out + OUT_VWS + ((size_t)((rr >> 3) * 128 + 120 + (rr & 7)) * 4 + wc) * 64 + 8 * fq; }
                    else if ((row & 2047) >= 1920) wdst = out + OUT_VWP + ((size_t)((row >> 11) * 128 + (row & 2047) - 1920) * 4 + wc) * 64 + 8 * fq;
#pragma unroll
                    for (int bj = 0; bj < 2; ++bj) {
                        const f32x4 v0 = acc[ai][bj][m][0], v1 = acc[ai][bj][m][1];
                        u32x4 w; w.x = pk2(v0[0], v0[1]); w.y = pk2(v0[2], v0[3]); w.z = pk2(v1[0], v1[1]); w.w = pk2(v1[2], v1[3]);
                        *(u32x4*)(Vb + (size_t)row * KVW + wc * 64 + 32 * bj + 8 * fq) = w;
                        if (wdst) { *(f32x4*)(wdst + 32 * bj) = v0; *(f32x4*)(wdst + 32 * bj + 4) = v1; }
                    }
                }
        } else {
            const bool isg = pn >= 10;
            bf16_t* dst = isg ? G : U; const int ct = isg ? pn - 10 : pn - 6;
#pragma unroll
            for (int ai = 0; ai < 2; ++ai)
#pragma unroll
                for (int m = 0; m < 4; ++m) {
                if (ai * 4 + m < rg0 || ai * 4 + m >= rg1) continue;
                    if (ai * 4 + m < rg0 || ai * 4 + m >= rg1) continue;
                    const int row = rbase + ai * 128 + m * 16;
                    float ss = 0.f;
#pragma unroll
                    for (int bj = 0; bj < 2; ++bj) {
                        f32x4 v0 = acc[ai][bj][m][0], v1 = acc[ai][bj][m][1];
                        { const f32x2 a = gelu2((f32x2){v0[0], v0[1]}), b2 = gelu2((f32x2){v0[2], v0[3]}), c2 = gelu2((f32x2){v1[0], v1[1]}), d2 = gelu2((f32x2){v1[2], v1[3]});
                          v0 = (f32x4){a.x, a.y, b2.x, b2.y}; v1 = (f32x4){c2.x, c2.y, d2.x, d2.y}; }
                        ss += (v0[0] * v0[0] + v0[1] * v0[1]) + (v0[2] * v0[2] + v0[3] * v0[3]) + (v1[0] * v1[0] + v1[1] * v1[1]) + (v1[2] * v1[2] + v1[3] * v1[3]);
                        u32x4 w; w.x = pk2(v0[0], v0[1]); w.y = pk2(v0[2], v0[3]); w.z = pk2(v1[0], v1[1]); w.w = pk2(v1[2], v1[3]);
                        *(u32x4*)(dst + (size_t)row * SGW + ct * 256 + wc * 64 + 32 * bj + 8 * fq) = w;
                    }
                    if (isg) { ss = fq_sum(ss); if (fq == 0) gss[(size_t)row * 16 + ct * 4 + wc] = ss; }
                }
        }
    }
};

struct EpiWo {
    Params p; bf16_t* HB; float* hss;
    __device__ __forceinline__ void operator()(const Acc& acc, const Unit& u, int wr, int wc, int fr, int fq, int rg0, int rg1) const {
        const int rbase = u.pm * 256 + wr * 64 + fr, cb = u.pn * 256 + wc * 64 + 8 * fq;
#pragma unroll
        for (int ai = 0; ai < 2; ++ai)
#pragma unroll
        for (int mh = 0; mh < 2; ++mh) {
            f32x4 xv[4][2][2];
#pragma unroll
            for (int m = 2 * mh; m < 2 * mh + 2; ++m) {
                if (ai * 4 + m < rg0 || ai * 4 + m >= rg1) continue;
                const float* xr = xrow(p, rbase + ai * 128 + m * 16) + cb;
#pragma unroll
                for (int bj = 0; bj < 2; ++bj) { xv[m][bj][0] = *(const f32x4*)(xr + 32 * bj); xv[m][bj][1] = *(const f32x4*)(xr + 32 * bj + 4); }
            }
#pragma unroll
            for (int m = 2 * mh; m < 2 * mh + 2; ++m) {
                if (ai * 4 + m < rg0 || ai * 4 + m >= rg1) continue;
                const int row = rbase + ai * 128 + m * 16;
                float ss = 0.f;
#pragma unroll
                for (int bj = 0; bj < 2; ++bj) {
                    const f32x4 h0 = xv[m][bj][0] + acc[ai][bj][m][0], h1 = xv[m][bj][1] + acc[ai][bj][m][1];
                    ss += (h0[0] * h0[0] + h0[1] * h0[1]) + (h0[2] * h0[2] + h0[3] * h0[3]) + (h1[0] * h1[0] + h1[1] * h1[1]) + (h1[2] * h1[2] + h1[3] * h1[3]);
                    u32x4 w; w.x = pk2(h0[0], h0[1]); w.y = pk2(h0[2], h0[3]); w.z = pk2(h1[0], h1[1]); w.w = pk2(h1[2], h1[3]);
                    *(u32x4*)(HB + (size_t)row * DM + cb + 32 * bj) = w;
                }
                ss = fq_sum(ss);
                if (fq == 0) hss[(size_t)row * 32 + u.pn * 4 + wc] = ss;
            }
        }
    }
};

struct EpiGU {
    const float* hss; bf16_t* ACT;
    __device__ __forceinline__ void operator()(const Acc& acc, const Unit& u, int wr, int wc, int fr, int fq, int rg0, int rg1) const {
        const int rbase = u.pm * 256 + wr * 64 + fr, cb = u.pn * 128 + wc * 32 + 8 * fq;
        float r8[8];
#pragma unroll
        for (int ai = 0; ai < 2; ++ai)
#pragma unroll
            for (int m = 0; m < 4; ++m) {
                r8[ai * 4 + m] = 0.f;
                if (ai * 4 + m < rg0 || ai * 4 + m >= rg1) continue;
                const f32x4* hp = (const f32x4*)(hss + (size_t)(rbase + ai * 128 + m * 16) * 32) + 2 * fq;
                const f32x4 t = hp[0] + hp[1];
                r8[ai * 4 + m] = (t[0] + t[1]) + (t[2] + t[3]);
            }
#pragma unroll
        for (int ai = 0; ai < 2; ++ai)
#pragma unroll
            for (int m = 0; m < 4; ++m) {
                if (ai * 4 + m < rg0 || ai * 4 + m >= rg1) continue;
                const int row = rbase + ai * 128 + m * 16;
                const float r = rsqrtf(fq_sum(r8[ai * 4 + m]) * (1.0f / DM) + EPS);
                const f32x4 g0 = acc[ai][0][m][0] * r, g1 = acc[ai][0][m][1] * r, u0 = acc[ai][1][m][0] * r, u1 = acc[ai][1][m][1] * r;
                const f32x2 p0 = silu_mul2((f32x2){g0[0], g0[1]}, (f32x2){u0[0], u0[1]}), p1 = silu_mul2((f32x2){g0[2], g0[3]}, (f32x2){u0[2], u0[3]});
                const f32x2 p2 = silu_mul2((f32x2){g1[0], g1[1]}, (f32x2){u1[0], u1[1]}), p3 = silu_mul2((f32x2){g1[2], g1[3]}, (f32x2){u1[2], u1[3]});
                const f32x4 a0 = (f32x4){p0.x, p0.y, p1.x, p1.y}, a1 = (f32x4){p2.x, p2.y, p3.x, p3.y};
                u32x4 w; w.x = pk2(a0[0], a0[1]); w.y = pk2(a0[2], a0[3]); w.z = pk2(a1[0], a1[1]); w.w = pk2(a1[2], a1[3]);
                __builtin_nontemporal_store(w, (u32x4*)(ACT + (size_t)row * FF + cb));
            }
    }
};

struct EpiDown {
    float* out; const bf16_t* HB;
    __device__ __forceinline__ void operator()(const Acc& acc, const Unit& u, int wr, int wc, int fr, int fq, int rg0, int rg1) const {
        const int rbase = u.pm * 256 + wr * 64 + fr, cb = u.pn * 256 + wc * 64 + 8 * fq;
#pragma unroll
        for (int ai = 0; ai < 2; ++ai) {
            u32x4 hv[4][2];
#pragma unroll
            for (int m = 0; m < 4; ++m) {
                if (ai * 4 + m < rg0 || ai * 4 + m >= rg1) continue;
                const bf16_t* hr = HB + (size_t)(rbase + ai * 128 + m * 16) * DM + cb;
#pragma unroll
                for (int bj = 0; bj < 2; ++bj) hv[m][bj] = *(const u32x4*)(hr + 32 * bj);
            }
#pragma unroll
            for (int m = 0; m < 4; ++m) {
                if (ai * 4 + m < rg0 || ai * 4 + m >= rg1) continue;
                float* yr = out + OUT_Y + (size_t)(rbase + ai * 128 + m * 16) * DM + cb;
#pragma unroll
                for (int bj = 0; bj < 2; ++bj) {
                    const u32x4 w = hv[m][bj];
                    const f32x4 h0 = (f32x4){bf_lo(w.x), bf_hi(w.x), bf_lo(w.y), bf_hi(w.y)}, h1 = (f32x4){bf_lo(w.z), bf_hi(w.z), bf_lo(w.w), bf_hi(w.w)};
                    __builtin_nontemporal_store(h0 + acc[ai][bj][m][0], (f32x4*)(yr + 32 * bj)); __builtin_nontemporal_store(h1 + acc[ai][bj][m][1], (f32x4*)(yr + 32 * bj + 4));
                }
            }
        }
    }
};

__device__ __forceinline__ void p0_transpose_item(const float* W, int K, int N, bf16_t* WT, int mode, const float* s0, const float* s1, int split,
                                                  LAS float* scr, int item, int lane) {
    const int nblk = N / 32, kb = item / nblk, nb = item % nblk, k0 = 64 * kb, n0 = 32 * nb;
#pragma unroll 8
    for (int i = 0; i < 32; ++i) { const int kk = 2 * i + (lane >> 5); scr[kk * 33 + (lane & 31)] = __builtin_nontemporal_load(W + (size_t)(k0 + kk) * N + n0 + (lane & 31)); }
    asm volatile("s_waitcnt lgkmcnt(0)" ::: "memory");
    const int c = lane & 7;
    float sc[8];
#pragma unroll
    for (int e = 0; e < 8; ++e) { const int k = k0 + 8 * c + e; sc[e] = s0 ? (k < split ? s0[k] : s1[k - split]) : 1.0f; }
    int rowbase;
    if (mode == 0) rowbase = (n0 >> 8) * 256 + ((n0 >> 5) & 1) * 128 + ((n0 >> 6) & 3) * 32;
    else rowbase = (n0 >> 7) * 256 + (mode - 1) * 128 + ((n0 >> 5) & 3) * 32;
#pragma unroll
    for (int j = 0; j < 4; ++j) {
        const int n = (lane >> 3) + 8 * j; const LAS float* s = scr + (8 * c) * 33 + n;
        const int pr = 16 * ((n >> 2) & 1) + 4 * (n >> 3) + (n & 3);
        u32x4 o; o.x = pk2(s[0 * 33] * sc[0], s[1 * 33] * sc[1]); o.y = pk2(s[2 * 33] * sc[2], s[3 * 33] * sc[3]); o.z = pk2(s[4 * 33] * sc[4], s[5 * 33] * sc[5]); o.w = pk2(s[6 * 33] * sc[6], s[7 * 33] * sc[7]);
        *(u32x4*)(WT + (size_t)(rowbase + pr) * K + k0 + 8 * c) = o;
    }
    asm volatile("s_waitcnt lgkmcnt(0)" ::: "memory");
}

__device__ __forceinline__ void sincos_pi(double r, double& s, double& c) {
    const double x2 = r * r;
    double ps = -1.0 / 1.0888869450418352e28;
    ps = ps * x2 + 1.0 / 1.5511210043330986e25;
    ps = ps * x2 - 1.0 / 2.585201673888498e22;
    ps = ps * x2 + 1.0 / 5.109094217170944e19;
    ps = ps * x2 - 1.0 / 1.21645100408832e17;
    ps = ps * x2 + 1.0 / 3.55687428096e14;
    ps = ps * x2 - 1.0 / 1.307674368e12;
    ps = ps * x2 + 1.0 / 6.2270208e9;
    ps = ps * x2 - 1.0 / 3.99168e7;
    ps = ps * x2 + 1.0 / 362880.0;
    ps = ps * x2 - 1.0 / 5040.0;
    ps = ps * x2 + 1.0 / 120.0;
    ps = ps * x2 - 1.0 / 6.0;
    ps = ps * x2 + 1.0;
    s = ps * r;
    double pc = -1.0 / 4.0329146112660565e26;
    pc = pc * x2 + 1.0 / 6.204484017332394e23;
    pc = pc * x2 - 1.0 / 1.1240007277776077e21;
    pc = pc * x2 + 1.0 / 2.43290200817664e18;
    pc = pc * x2 - 1.0 / 6.402373705728e15;
    pc = pc * x2 + 1.0 / 2.0922789888e13;
    pc = pc * x2 - 1.0 / 8.71782912e10;
    pc = pc * x2 + 1.0 / 4.790016e8;
    pc = pc * x2 - 1.0 / 3628800.0;
    pc = pc * x2 + 1.0 / 40320.0;
    pc = pc * x2 - 1.0 / 720.0;
    pc = pc * x2 + 1.0 / 24.0;
    pc = pc * x2 - 0.5;
    pc = pc * x2 + 1.0;
    c = pc;
}

__device__ __forceinline__ void p0_prologue(const Params& p, LAS unsigned char* lds) {
    const int tid = opaque(threadIdx.x), lane = tid & 63, wave = __builtin_amdgcn_readfirstlane(tid >> 6);
    unsigned char* ws = p.ws;
    const int G = gridDim.x, gw = blockIdx.x * 8 + wave, NGW = G * 8;
    LAS float* scr = (LAS float*)(lds + wave * 16384);
    constexpr int I_IN = (DM / 64) * (INW / 32), I_O = (DM / 64) * (DM / 32), I_G = (DM / 64) * (FF / 32), I_D = (FF / 64) * (DM / 32);
    constexpr int NITEMS = I_IN + I_O + 2 * I_G + I_D;
    for (int it = gw; it < NITEMS; it += NGW) {
        int r = it;
        if (r < I_IN) { p0_transpose_item(p.w_in, DM, INW, (bf16_t*)(ws + OFF_WIN), 0, nullptr, nullptr, 0, scr, r, lane); continue; } r -= I_IN;
        if (r < I_O) { p0_transpose_item(p.w_o, DM, DM, (bf16_t*)(ws + OFF_WO), 0, p.attn_out_norm, p.sg_out_norm, AW, scr, r, lane); continue; } r -= I_O;
        if (r < I_G) { p0_transpose_item(p.w_gate, DM, FF, (bf16_t*)(ws + OFF_WGU), 1, p.ffn_norm, p.ffn_norm, DM, scr, r, lane); continue; } r -= I_G;
        if (r < I_G) { p0_transpose_item(p.w_up, DM, FF, (bf16_t*)(ws + OFF_WGU), 2, p.ffn_norm, p.ffn_norm, DM, scr, r, lane); continue; } r -= I_G;
        p0_transpose_item(p.w_down, FF, DM, (bf16_t*)(ws + OFF_WDN), 0, nullptr, nullptr, 0, scr, r, lane);
    }
    bf16_t* XN = (bf16_t*)(ws + OFF_XN);
    for (int m = gw; m < MT; m += NGW) {
        const f32x4* xr = (const f32x4*)xrow(p, m) + lane;
        f32x4 v[8]; float s = 0.f;
#pragma unroll
        for (int j = 0; j < 8; ++j) { v[j] = xr[64 * j]; s += (v[j][0] * v[j][0] + v[j][1] * v[j][1]) + (v[j][2] * v[j][2] + v[j][3] * v[j][3]); }
        const float r = rsqrtf(wave_sum(s) * (1.0f / DM) + EPS);
        u32x2* o8 = (u32x2*)(XN + (size_t)m * DM) + lane;
#pragma unroll
        for (int j = 0; j < 8; ++j) { const f32x4 w = ((const f32x4*)p.attn_norm)[lane + 64 * j]; const f32x4 y = v[j] * r * w; u32x2 o; o.x = pk2(y[0], y[1]); o.y = pk2(y[2], y[3]); o8[64 * j] = o; }
    }
    const int gt = blockIdx.x * 512 + tid, NT = G * 512;
    float* rope = (float*)(ws + OFF_ROPE);
    for (int e = gt; e < NROPE * 32; e += NT) {
        const int pi = e >> 5, i = e & 31;
        const double pos = pi < 2048 ? (double)pi : (double)(16384 + pi - 2048);
        const double a = pos * ROPE_INV[i];
        const double k = __builtin_rint(a * 0.15915494309189535);
        double r = __builtin_fma(-k, 6.283185307179586, a); r = __builtin_fma(-k, 2.4492935982947064e-16, r);
        double s, c; sincos_pi(r, s, c);
        rope[pi * 64 + i] = (float)c; rope[pi * 64 + 32 + i] = (float)s;
    }
    bf16_t* wsg = (bf16_t*)(ws + OFF_WSG);
    for (int e = gt; e < 8 * 128 * 128 / 2; e += NT) {
        const int idx = 2 * e, j = idx & 127, i = (idx >> 7) & 127;
        const float a = j <= i ? p.sg_w[idx] : 0.f, b = (j + 1) <= i ? p.sg_w[idx + 1] : 0.f;
        ((unsigned*)wsg)[e] = pk2(a, b);
    }
}

constexpr int KROW = 144;
constexpr int KVH_BYTES = 160 * KROW;
constexpr int GROW = 544;
constexpr int L_K = 0, L_V = 2 * KVH_BYTES, L_RED = 4 * KVH_BYTES  , L_RG = L_RED + 32 * 8 * 4;
constexpr int GBUF = 128 * GROW  , L_RED2 = 2 * GBUF  , L_RG2 = L_RED2 + 32 * 8 * 4;

__device__ __forceinline__ s16x4 ldtr(const LAS unsigned char* p) { return __builtin_bit_cast(s16x4, __builtin_amdgcn_ds_read_tr16_b64_v4i16((LAS s16x4*)p)); }

template <int NQB>
__device__ __forceinline__ void attn_core(const LAS unsigned char* Kl, const LAS unsigned char* Vl, const bf16x8 (&qf)[NQB][2], float sink, int kmin,
                                          f32x4 (&o)[NQB][4], int lane) {
    const int fr = lane & 15, fq = lane >> 4, tq = (lane & 15) >> 2, tp = lane & 3;
#pragma unroll
    for (int qb = 0; qb < NQB; ++qb) {
        asm volatile("" ::: "memory");
        const int qi = 16 * qb + fr;
        const bf16x8 q0 = qf[qb][0], q1 = qf[qb][1];
        f32x4 s[10];
#pragma unroll
        for (int t = 0; t < 10; ++t) {
            const LAS unsigned char* kp = Kl + (16 * t + fr) * KROW + 16 * fq;
            const bf16x8 k0 = *(const LAS bf16x8*)kp, k1 = *(const LAS bf16x8*)(kp + 64);
            s[t] = __builtin_amdgcn_mfma_f32_16x16x32_bf16(k0, q0, (f32x4){0.f, 0.f, 0.f, 0.f}, 0, 0, 0);
            s[t] = __builtin_amdgcn_mfma_f32_16x16x32_bf16(k1, q1, s[t], 0, 0, 0);
            if (t & 1) __builtin_amdgcn_sched_barrier(0);
        }
        float mx = -INFINITY;
#pragma unroll
        for (int t = 0; t < 10; ++t)
#pragma unroll
            for (int j = 0; j < 4; ++j) {
                const int kj = 16 * t + 4 * fq + j, diff = 128 + qi - kj;
                const bool valid = (diff >= 0) && (diff < 128) && (kj >= kmin);
                s[t][j] = valid ? s[t][j] : -INFINITY;
                mx = fmaxf(mx, s[t][j]);
            }
        mx = fmaxf(fq_max(mx), sink);
        float sum = 0.f;
#pragma unroll
        for (int t = 0; t < 10; ++t)
#pragma unroll
            for (int j = 0; j < 4; ++j) { const float e = __expf(s[t][j] - mx); s[t][j] = e; sum += e; }
        sum = fq_sum(sum) + __expf(sink - mx);
        const float inv = 1.0f / sum;
#pragma unroll
        for (int dt = 0; dt < 4; ++dt) o[qb][dt] = (f32x4){0.f, 0.f, 0.f, 0.f};
#pragma unroll
        for (int T = 0; T < 5; ++T) {
            u32x4 pw; pw.x = pk2(s[2 * T][0] * inv, s[2 * T][1] * inv); pw.y = pk2(s[2 * T][2] * inv, s[2 * T][3] * inv);
            pw.z = pk2(s[2 * T + 1][0] * inv, s[2 * T + 1][1] * inv); pw.w = pk2(s[2 * T + 1][2] * inv, s[2 * T + 1][3] * inv);
            const bf16x8 pf = __builtin_bit_cast(bf16x8, pw);
            const LAS unsigned char* vp = Vl + (32 * T + 4 * fq + tq) * KROW + 8 * tp;
#pragma unroll
            for (int dt = 0; dt < 4; ++dt) {
                const s16x4 lo = ldtr(vp + 32 * dt), hi = ldtr(vp + 16 * KROW + 32 * dt);
                const bf16x8 vf = __builtin_shufflevector(lo, hi, 0, 1, 2, 3, 4, 5, 6, 7);
                o[qb][dt] = __builtin_amdgcn_mfma_f32_16x16x32_bf16(vf, pf, o[qb][dt], 0, 0, 0);
            }
            __builtin_amdgcn_sched_barrier(0);
        }
    }
}

template <int NQB>
__device__ __forceinline__ void load_q(bf16x8 (&qf)[NQB][2], const bf16_t* Qg  , int nq, int lane) {
    const int fr = lane & 15, fq = lane >> 4;
#pragma unroll
    for (int qb = 0; qb < NQB; ++qb) {
        const int qi = 16 * qb + fr, qic = qi < nq ? qi : nq - 1;
        const bf16_t* qp = Qg + (size_t)qic * AW + 8 * fq;
        qf[qb][0] = *(const bf16x8*)qp; qf[qb][1] = *(const bf16x8*)(qp + 32);
    }
}
__device__ __forceinline__ float rowscale16(const float* ss16) {
    const f32x4* q = (const f32x4*)ss16; const f32x4 t = (q[0] + q[1]) + (q[2] + q[3]);
    return rsqrtf(((t[0] + t[1]) + (t[2] + t[3])) * (1.0f / 1024.0f) + EPS);
}

__device__ __forceinline__ void p2_prompt_att(const Params& p, LAS unsigned char* lds, int unit) {
    const int tid = opaque(threadIdx.x), lane = tid & 63, wave = __builtin_amdgcn_readfirstlane(tid >> 6);
    unsigned char* ws = p.ws;
    const bf16_t* Q = (const bf16_t*)(ws + OFF_Q); const bf16_t* Kb = (const bf16_t*)(ws + OFF_KB); const bf16_t* Vb = (const bf16_t*)(ws + OFF_VB);
    const bf16_t* U = (const bf16_t*)(ws + OFF_U); const bf16_t* Gm = (const bf16_t*)(ws + OFF_G); bf16_t* MIX = (bf16_t*)(ws + OFF_MIX);
    const float* gss = (const float*)(ws + OFF_GSS); const bf16_t* wsg = (const bf16_t*)(ws + OFF_WSG);
    const int b = unit >> 6, s0 = (unit & 63) * 32, row0 = b * 2048 + s0;
    const int fr = lane & 15, fq = lane >> 4, tq = (lane & 15) >> 2, tp = lane & 3;
    LAS float* red = (LAS float*)(lds + L_RED);
    LAS float* rgl = (LAS float*)(lds + L_RG);
    {
        f32x4 o[2][2][4];
        const int kmin = s0 < 128 ? 128 - s0 : 0;
        u32x4 kr[5], vr[5];
#define ATT_LOADKV(ps_) do { _Pragma("unroll") for (int it = 0; it < 5; ++it) { const int c_ = tid + 512 * it, kj_ = c_ >> 4, ch_ = c_ & 15, kp_ = s0 - 128 + kj_; \
            kr[it] = (u32x4){0u, 0u, 0u, 0u}; vr[it] = kr[it]; \
            if (kp_ >= 0) { const size_t g_ = (size_t)(b * 2048 + kp_) * KVW + 128 * (ps_) + ch_ * 8; kr[it] = *(const u32x4*)(Kb + g_); vr[it] = *(const u32x4*)(Vb + g_); } } } while (0)
#define ATT_STOREKV() do { _Pragma("unroll") for (int it = 0; it < 5; ++it) { const int c_ = tid + 512 * it, kj_ = c_ >> 4, ch_ = c_ & 15; \
            const int off_ = ((ch_ >> 3) * 160 + kj_) * KROW + (ch_ & 7) * 16; *(LAS u32x4*)(lds + L_K + off_) = kr[it]; *(LAS u32x4*)(lds + L_V + off_) = vr[it]; } } while (0)
        bf16x8 qf[2][2];
        ATT_LOADKV(0);
        load_q<2>(qf, Q + (size_t)row0 * AW + wave * 64, 32, lane);
        const float sink0 = p.sinks[wave], sink1 = p.sinks[8 + wave];
        ATT_STOREKV();
        __syncthreads();
        ATT_LOADKV(1);
        attn_core<2>(lds + L_K + (wave >> 2) * KVH_BYTES, lds + L_V + (wave >> 2) * KVH_BYTES, qf, sink0, kmin, o[0], lane);
        load_q<2>(qf, Q + (size_t)row0 * AW + (8 + wave) * 64, 32, lane);
        __syncthreads();
        ATT_STOREKV();
        __syncthreads();
        attn_core<2>(lds + L_K + (wave >> 2) * KVH_BYTES, lds + L_V + (wave >> 2) * KVH_BYTES, qf, sink1, kmin, o[1], lane);
#undef ATT_LOADKV
#undef ATT_STOREKV
#pragma unroll
        for (int qb = 0; qb < 2; ++qb) {
            float ss = 0.f;
#pragma unroll
            for (int ps = 0; ps < 2; ++ps)
#pragma unroll
                for (int dt = 0; dt < 4; ++dt) { const f32x4 v = o[ps][qb][dt]; ss += (v[0] * v[0] + v[1] * v[1]) + (v[2] * v[2] + v[3] * v[3]); }
            ss = fq_sum(ss);
            if (fq == 0) red[(16 * qb + fr) * 8 + wave] = ss;
        }
        __syncthreads();
#pragma unroll
        for (int qb = 0; qb < 2; ++qb) {
            const LAS f32x4* rr = (const LAS f32x4*)(red + (16 * qb + fr) * 8); const f32x4 t = rr[0] + rr[1];
            const float ra = rsqrtf(((t[0] + t[1]) + (t[2] + t[3])) * (1.0f / 1024.0f) + EPS);
#pragma unroll
            for (int ps = 0; ps < 2; ++ps)
#pragma unroll
                for (int dt = 0; dt < 4; ++dt) {
                    const f32x4 v = o[ps][qb][dt] * ra; u32x2 w; w.x = pk2(v[0], v[1]); w.y = pk2(v[2], v[3]);
                    *(u32x2*)(MIX + (size_t)(row0 + 16 * qb + fr) * DM + (8 * ps + wave) * 64 + 16 * dt + 4 * fq) = w;
                }
        }
        __syncthreads();
    }
}
__device__ __forceinline__ void p2_prompt_sg(const Params& p, LAS unsigned char* lds, int unit) {
    const int tid = opaque(threadIdx.x), lane = tid & 63, wave = __builtin_amdgcn_readfirstlane(tid >> 6);
    unsigned char* ws = p.ws;
    const bf16_t* U = (const bf16_t*)(ws + OFF_U); const bf16_t* Gm = (const bf16_t*)(ws + OFF_G); bf16_t* MIX = (bf16_t*)(ws + OFF_MIX);
    const float* gss = (const float*)(ws + OFF_GSS); const bf16_t* wsg = (const bf16_t*)(ws + OFF_WSG);
    const int b = unit >> 6, s0 = (unit & 63) * 32, row0 = b * 2048 + s0;
    const int fr = lane & 15, fq = lane >> 4, tq = (lane & 15) >> 2, tp = lane & 3;
    LAS float* red = (LAS float*)(lds + L_RED2);
    LAS float* rgl = (LAS float*)(lds + L_RG2);
    {
        const int c = (s0 >> 5) & 3, crow0 = b * 2048 + (s0 & ~127), nrows = 32 * (c + 1), nk = 2 * (c + 1);
        const int sj = tid >> 5, sch = tid & 31;
        u32x4 gv[8]; f32x4 gn0, gn1;
#define SG_LOADG(ps_) do { _Pragma("unroll") for (int k = 0; k < 8; ++k) if (k < nk) gv[k] = *(const u32x4*)(Gm + (size_t)(crow0 + sj + 16 * k) * SGW + 256 * (ps_) + 8 * sch); \
            gn0 = *(const f32x4*)(p.sg_norm + 256 * (ps_) + 8 * sch); gn1 = *(const f32x4*)(p.sg_norm + 256 * (ps_) + 8 * sch + 4); } while (0)
#define SG_STOREG(buf_) do { _Pragma("unroll") for (int k = 0; k < 8; ++k) if (k < nk) { const float r_ = rgl[sj + 16 * k]; const f32x4 n0_ = gn0 * r_, n1_ = gn1 * r_; const u32x4 g_ = gv[k]; u32x4 w_; \
            w_.x = pk2(bf_lo(g_.x) * n0_[0], bf_hi(g_.x) * n0_[1]); w_.y = pk2(bf_lo(g_.y) * n0_[2], bf_hi(g_.y) * n0_[3]); \
            w_.z = pk2(bf_lo(g_.z) * n1_[0], bf_hi(g_.z) * n1_[1]); w_.w = pk2(bf_lo(g_.w) * n1_[2], bf_hi(g_.w) * n1_[3]); \
            *(LAS u32x4*)(lds + (buf_) * GBUF + (sj + 16 * k) * GROW + sch * 16) = w_; } } while (0)
        SG_LOADG(0);
        if (tid < nrows) rgl[tid] = rowscale16(gss + (size_t)(crow0 + tid) * 16);
        __syncthreads();
        SG_STOREG(0);
        __syncthreads();
        f32x4 sg[4][2][2];
#pragma unroll
        for (int ps = 0; ps < 4; ++ps) {
            const int hl = wave >> 2, head = 2 * ps + hl, dq = wave & 3;
            if (ps < 3) SG_LOADG(ps + 1);
            bf16x8 wf[4][2]; u32x2 uv[2][2]; float bias[2];
#pragma unroll
            for (int J = 0; J < 4; ++J)
                if (J <= c) {
#pragma unroll
                    for (int ib = 0; ib < 2; ++ib) wf[J][ib] = *(const bf16x8*)(wsg + ((size_t)(head * 128 + 32 * c + 16 * ib + fr) * 128 + 32 * J + 8 * fq));
                }
#pragma unroll
            for (int ib = 0; ib < 2; ++ib) {
                bias[ib] = p.sg_b[head * 128 + 32 * c + 16 * ib + fr];
#pragma unroll
                for (int dt = 0; dt < 2; ++dt) uv[ib][dt] = *(const u32x2*)(U + (size_t)(row0 + 16 * ib + fr) * SGW + head * 128 + 32 * dq + 16 * dt + 4 * fq);
            }
            f32x4 a[2][2];
#pragma unroll
            for (int ib = 0; ib < 2; ++ib)
#pragma unroll
                for (int dt = 0; dt < 2; ++dt) a[ib][dt] = (f32x4){0.f, 0.f, 0.f, 0.f};
#pragma unroll
            for (int J = 0; J < 4; ++J)
                if (J <= c) {
                    const LAS unsigned char* gp = lds + (ps & 1) * GBUF + (32 * J + 8 * fq + tq) * GROW + (128 * hl + 32 * dq + 4 * tp) * 2;
#pragma unroll
                    for (int dt = 0; dt < 2; ++dt) {
                        const s16x4 lo = ldtr(gp + 32 * dt), hi = ldtr(gp + 4 * GROW + 32 * dt);
                        const bf16x8 gf = __builtin_shufflevector(lo, hi, 0, 1, 2, 3, 4, 5, 6, 7);
#pragma unroll
                        for (int ib = 0; ib < 2; ++ib) a[ib][dt] = __builtin_amdgcn_mfma_f32_16x16x32_bf16(gf, wf[J][ib], a[ib][dt], 0, 0, 0);
                    }
                }
#pragma unroll
            for (int ib = 0; ib < 2; ++ib)
#pragma unroll
                for (int dt = 0; dt < 2; ++dt) {
                    f32x4 v = a[ib][dt] + bias[ib];
                    v[0] *= bf_lo(uv[ib][dt].x); v[1] *= bf_hi(uv[ib][dt].x); v[2] *= bf_lo(uv[ib][dt].y); v[3] *= bf_hi(uv[ib][dt].y);
                    sg[ps][ib][dt] = v;
                }
            if (ps < 3) SG_STOREG((ps + 1) & 1);
            __syncthreads();
        }
#undef SG_LOADG
#undef SG_STOREG
#pragma unroll
        for (int ib = 0; ib < 2; ++ib) {
            float ss = 0.f;
#pragma unroll
            for (int ps = 0; ps < 4; ++ps)
#pragma unroll
                for (int dt = 0; dt < 2; ++dt) { const f32x4 v = sg[ps][ib][dt]; ss += (v[0] * v[0] + v[1] * v[1]) + (v[2] * v[2] + v[3] * v[3]); }
            ss = fq_sum(ss);
            if (fq == 0) red[(16 * ib + fr) * 8 + wave] = ss;
        }
        __syncthreads();
#pragma unroll
        for (int ib = 0; ib < 2; ++ib) {
            const LAS f32x4* rr = (const LAS f32x4*)(red + (16 * ib + fr) * 8); const f32x4 t = rr[0] + rr[1];
            const float rs = rsqrtf(((t[0] + t[1]) + (t[2] + t[3])) * (1.0f / 1024.0f) + EPS);
#pragma unroll
            for (int ps = 0; ps < 4; ++ps)
#pragma unroll
                for (int dt = 0; dt < 2; ++dt) {
                    const f32x4 v = sg[ps][ib][dt] * rs; u32x2 w; w.x = pk2(v[0], v[1]); w.y = pk2(v[2], v[3]);
                    *(u32x2*)(MIX + (size_t)(row0 + 16 * ib + fr) * DM + AW + (2 * ps + (wave >> 2)) * 128 + 32 * (wave & 3) + 16 * dt + 4 * fq) = w;
                }
        }
        __syncthreads();
    }
}

__device__ __forceinline__ void p2_sample_unit(const Params& p, LAS unsigned char* lds, int b) {
    const int tid = opaque(threadIdx.x), lane = tid & 63, wave = __builtin_amdgcn_readfirstlane(tid >> 6);
    unsigned char* ws = p.ws;
    const bf16_t* Q = (const bf16_t*)(ws + OFF_Q); const bf16_t* Kb = (const bf16_t*)(ws + OFF_KB); const bf16_t* Vb = (const bf16_t*)(ws + OFF_VB);
    const bf16_t* U = (const bf16_t*)(ws + OFF_U); const bf16_t* Gm = (const bf16_t*)(ws + OFF_G); bf16_t* MIX = (bf16_t*)(ws + OFF_MIX);
    const float* gss = (const float*)(ws + OFF_GSS);
    const int row0 = MP + 8 * b, fr = lane & 15, fq = lane >> 4;
    LAS float* red = (LAS float*)(lds + L_RED);
    LAS float* rgl = (LAS float*)(lds + L_RG);
    {
        f32x4 o[2][1][4];
#pragma unroll
        for (int ps = 0; ps < 2; ++ps) {
            bf16x8 qf1[1][2];
            load_q<1>(qf1, Q + (size_t)row0 * AW + (8 * ps + wave) * 64, 8, lane);
            const float sinkv = p.sinks[8 * ps + wave];
            {
                const int kr = tid >> 4, ch = tid & 15;
                f32x4 ck[4][2], cv[4][2]; u32x4 nk = (u32x4){0u, 0u, 0u, 0u}, nv = nk;
#pragma unroll
                for (int it = 0; it < 4; ++it) {
                    const size_t g = ((size_t)(b * 128 + kr + 32 * it)) * KVW + 128 * ps + ch * 8;
                    ck[it][0] = *(const f32x4*)(p.cache_k + g); ck[it][1] = *(const f32x4*)(p.cache_k + g + 4); cv[it][0] = *(const f32x4*)(p.cache_v + g); cv[it][1] = *(const f32x4*)(p.cache_v + g + 4);
                }
                if (kr < 8) { const size_t g = (size_t)(row0 + kr) * KVW + 128 * ps + ch * 8; nk = *(const u32x4*)(Kb + g); nv = *(const u32x4*)(Vb + g); }
#pragma unroll
                for (int it = 0; it < 4; ++it) {
                    const int kj = kr + 32 * it;
                    const f32x4 k0 = ck[it][0], k1 = ck[it][1], v0 = cv[it][0], v1 = cv[it][1];
                    u32x4 kv, vv;
                    kv.x = pk2(k0[0], k0[1]); kv.y = pk2(k0[2], k0[3]); kv.z = pk2(k1[0], k1[1]); kv.w = pk2(k1[2], k1[3]);
                    vv.x = pk2(v0[0], v0[1]); vv.y = pk2(v0[2], v0[3]); vv.z = pk2(v1[0], v1[1]); vv.w = pk2(v1[2], v1[3]);
                    if (kj >= 8) {
                        const size_t d = ((size_t)(b * 128 + kj - 8)) * KVW + 128 * ps + ch * 8;
                        float* kd = p.out + OUT_KWS + d; float* vd = p.out + OUT_VWS + d;
                        *(f32x4*)kd = k0; *(f32x4*)(kd + 4) = k1; *(f32x4*)vd = v0; *(f32x4*)(vd + 4) = v1;
                    }
                    const int off = ((ch >> 3) * 160 + kj) * KROW + (ch & 7) * 16;
                    *(LAS u32x4*)(lds + L_K + off) = kv; *(LAS u32x4*)(lds + L_V + off) = vv;
                }
                const int off4 = ((ch >> 3) * 160 + 128 + kr) * KROW + (ch & 7) * 16;
                *(LAS u32x4*)(lds + L_K + off4) = nk; *(LAS u32x4*)(lds + L_V + off4) = nv;
            }
            __syncthreads();
            const int head = 8 * ps + wave, kvl = wave >> 2;
            attn_core<1>(lds + L_K + kvl * KVH_BYTES, lds + L_V + kvl * KVH_BYTES, qf1, sinkv, 0, o[ps], lane);
            __syncthreads();
        }
        float ss = 0.f;
#pragma unroll
        for (int ps = 0; ps < 2; ++ps)
#pragma unroll
            for (int dt = 0; dt < 4; ++dt) { const f32x4 v = o[ps][0][dt]; ss += (v[0] * v[0] + v[1] * v[1]) + (v[2] * v[2] + v[3] * v[3]); }
        ss = fq_sum(ss);
        if (fq == 0) red[fr * 8 + wave] = ss;
        __syncthreads();
        {
            const LAS f32x4* rr = (const LAS f32x4*)(red + fr * 8); const f32x4 t = rr[0] + rr[1];
            const float ra = rsqrtf(((t[0] + t[1]) + (t[2] + t[3])) * (1.0f / 1024.0f) + EPS);
            if (fr < 8) {
#pragma unroll
                for (int ps = 0; ps < 2; ++ps)
#pragma unroll
                    for (int dt = 0; dt < 4; ++dt) {
                        const f32x4 v = o[ps][0][dt] * ra; u32x2 w; w.x = pk2(v[0], v[1]); w.y = pk2(v[2], v[3]);
                        *(u32x2*)(MIX + (size_t)(row0 + fr) * DM + (8 * ps + wave) * 64 + 16 * dt + 4 * fq) = w;
                    }
            }
        }
        __syncthreads();
    }
}
__device__ __forceinline__ void p2_sample_sg(const Params& p, LAS unsigned char* lds, int b) {
    const int tid = opaque(threadIdx.x), lane = tid & 63, wave = __builtin_amdgcn_readfirstlane(tid >> 6);
    unsigned char* ws = p.ws;
    const bf16_t* U = (const bf16_t*)(ws + OFF_U); const bf16_t* Gm = (const bf16_t*)(ws + OFF_G); bf16_t* MIX = (bf16_t*)(ws + OFF_MIX);
    const float* gss = (const float*)(ws + OFF_GSS);
    const int row0 = MP + 8 * b;
    LAS float* red = (LAS float*)(lds + L_RED);
    LAS float* rgl = (LAS float*)(lds + L_RG);
    {
        if (tid < 8) rgl[tid] = rowscale16(gss + (size_t)(row0 + tid) * 16);
        __syncthreads();
        const int col = 2 * tid, h = col >> 7;
        const float n0 = p.sg_norm[col], n1 = p.sg_norm[col + 1];
        float g0[8], g1[8];
#pragma unroll
        for (int j = 0; j < 8; ++j) {
            const unsigned gv = *(const unsigned*)(Gm + (size_t)(row0 + j) * SGW + col); const float r = rgl[j];
            g0[j] = bf_lo(gv) * r * n0; g1[j] = bf_hi(gv) * r * n1;
            float* sv = p.out + OUT_SGV + (size_t)(b * 8 + j) * SGW + col; sv[0] = g0[j]; sv[1] = g1[j];
        }
        float o0[8], o1[8];
#pragma unroll
        for (int i = 0; i < 8; ++i) {
            float m0 = p.sg_b[h * 128 + i], m1 = m0;
#pragma unroll
            for (int j = 0; j <= i; ++j) { const float w = p.sg_w[(size_t)(h * 128 + i) * 128 + j]; m0 += w * g0[j]; m1 += w * g1[j]; }
            const unsigned uv = *(const unsigned*)(U + (size_t)(row0 + i) * SGW + col);
            o0[i] = m0 * bf_lo(uv); o1[i] = m1 * bf_hi(uv);
            const float ss = wave_sum(o0[i] * o0[i] + o1[i] * o1[i]);
            if (lane == 0) red[i * 8 + wave] = ss;
        }
        __syncthreads();
#pragma unroll
        for (int i = 0; i < 8; ++i) {
            const LAS f32x4* rr = (const LAS f32x4*)(red + i * 8); const f32x4 t = rr[0] + rr[1];
            const float rs = rsqrtf(((t[0] + t[1]) + (t[2] + t[3])) * (1.0f / 1024.0f) + EPS);
            *(unsigned*)(MIX + (size_t)(row0 + i) * DM + AW + col) = pk2(o0[i] * rs, o1[i] * rs);
        }
        __syncthreads();
    }
}


typedef unsigned gu32;
#define XB_TMO      128
#define XB_XCNT(j)  (256  + 64 * (j))
#define XB_XSUB(j)  (1280 + 64 * (j))
#define XB_XGEN(j)  (2304 + 64 * (j))
#define XB_TOP      3328
#define XB_TOPGEN   3392
#define XCD_BAR_WORDS 3456
#define XB_SPIN_CAP (1u << 18)
__device__ __forceinline__ unsigned xb_ld(unsigned* p)              { return __hip_atomic_load(p, __ATOMIC_RELAXED, __HIP_MEMORY_SCOPE_AGENT); }
__device__ __forceinline__ unsigned xb_add(unsigned* p, unsigned v) { return __hip_atomic_fetch_add(p, v, __ATOMIC_RELAXED, __HIP_MEMORY_SCOPE_AGENT); }
__device__ __forceinline__ unsigned xb_xcc_id() { return (unsigned)__builtin_amdgcn_s_getreg((3 << 11) | 20) & 0xFu; }
#define XB_SPIN(cond, bar) do { unsigned _sp = 0; while (cond) { __builtin_amdgcn_s_sleep(1); \
    if ((++_sp & 255u) == 0u) { if (xb_ld(&(bar)[XB_TMO])) break; if (_sp > XB_SPIN_CAP) { atomicAdd(&(bar)[XB_TMO], 1u); break; } } } } while (0)
struct XcdBarrier { unsigned* bar; unsigned x; volatile LAS unsigned* st; };
__device__ __forceinline__ XcdBarrier xcd_barrier_post(unsigned* bar, volatile LAS unsigned* st) {
    XcdBarrier b; b.bar = bar; b.x = xb_xcc_id(); b.st = st;
    if (threadIdx.x == 0) (void)xb_add(&bar[XB_XCNT(b.x)], 1u);
    return b;
}
__device__ __forceinline__ void xcd_barrier_complete(unsigned* bar, unsigned x, unsigned& nloc, unsigned& nx) {
    const unsigned G = gridDim.x * gridDim.y * gridDim.z;
    unsigned sum, cnt, mine, sp = 0u;
    for (;;) {
        sum = 0u; cnt = 0u; mine = 0u;
#pragma unroll
        for (unsigned j = 0; j < 16; ++j) { const unsigned c = xb_ld(&bar[XB_XCNT(j)]); sum += c; cnt += (c > 0u) ? 1u : 0u; mine = (j == x) ? c : mine; }
        if (sum == G) break;
        __builtin_amdgcn_s_sleep(1);
        if ((++sp & 255u) == 0u) { if (xb_ld(&bar[XB_TMO])) break; if (sp > XB_SPIN_CAP) { atomicAdd(&bar[XB_TMO], 1u); break; } }
    }
    nloc = mine > 0u ? mine : 1u; nx = cnt > 0u ? cnt : 1u;
}
__device__ __forceinline__ void xcd_barrier(const XcdBarrier& b) {
    asm volatile("s_waitcnt vmcnt(0)" ::: "memory");
    __syncthreads();
    if (threadIdx.x == 0) {
        unsigned* bar = b.bar;
        __builtin_amdgcn_s_waitcnt(0);
        unsigned nloc = b.st[0], nx = b.st[1];
        if (nloc == 0u) { xcd_barrier_complete(bar, b.x, nloc, nx); b.st[0] = nloc; b.st[1] = nx; }
        const unsigned old = xb_add(&bar[XB_XSUB(b.x)], 1u);
        const unsigned gen = old / nloc;
        if (old + 1u == (gen + 1u) * nloc) {
            __builtin_amdgcn_fence(__ATOMIC_RELEASE, "agent");
            asm volatile("s_waitcnt vmcnt(0)" ::: "memory");
            const unsigned og = xb_add(&bar[XB_TOP], 1u);
            const unsigned tg = og / nx;
            if (og + 1u == (tg + 1u) * nx) xb_add(&bar[XB_TOPGEN], 1u);
            else XB_SPIN(xb_ld(&bar[XB_TOPGEN]) == tg, bar);
            __builtin_amdgcn_fence(__ATOMIC_ACQUIRE, "agent");
            xb_add(&bar[XB_XGEN(b.x)], 1u);
            asm volatile("s_waitcnt vmcnt(0)" ::: "memory");
        } else {
            XB_SPIN(xb_ld(&bar[XB_XGEN(b.x)]) == gen, bar);
            __builtin_amdgcn_fence(__ATOMIC_ACQUIRE, "agent");
            asm volatile("s_waitcnt vmcnt(0)" ::: "memory");
        }
    }
    __syncthreads();
}

#ifndef P3_MAXSF
#define P3_MAXSF 4
#endif
#ifndef P4_MAXSF
#define P4_MAXSF 4
#endif
#ifndef REP_P0
#define REP_P0 0
#endif
#ifndef REP_P2
#define REP_P2 0
#endif
#ifndef REP_P1
#define REP_P1 0
#endif
#ifndef REP_P3
#define REP_P3 0
#endif
#ifndef REP_P4
#define REP_P4 0
#endif
#ifndef EXTRA_SYNCS
#define EXTRA_SYNCS 0
#endif
#ifndef USE_CG_SYNC
#define USE_CG_SYNC 0
#endif
constexpr int LDS_BYTES = 147456;
__global__ void __launch_bounds__(512, 2) hymba_fwd(Params p) {
    extern __shared__ __attribute__((aligned(16))) unsigned char lds_raw[];
    LAS unsigned char* lds = (LAS unsigned char*)lds_raw;
    cg::grid_group grid = cg::this_grid();
    const int G = gridDim.x;
    unsigned char* ws = p.ws;
    volatile LAS unsigned* bst = (volatile LAS unsigned*)(lds + 147200);
    if (threadIdx.x < 2) bst[threadIdx.x] = 0u;
    __syncthreads();
    const XcdBarrier xbar = xcd_barrier_post((unsigned*)(ws + OFF_BAR), bst);
    if (p.out == nullptr) grid.sync();
#if USE_CG_SYNC
#define SEAM() grid.sync()
#else
#define SEAM() xcd_barrier(xbar)
#endif

#pragma unroll 1
    for (int rep = 0; rep <= REP_P0; ++rep) {
    p0_prologue(p, lds);
    SEAM();
    }
#pragma unroll 1
    for (int rep = 0; rep < EXTRA_SYNCS; ++rep) SEAM();
#pragma unroll 1
    for (int rep1 = 0; rep1 <= REP_P1; ++rep1) {
        pg8::Gemm g{(const bf16_t*)(ws + OFF_XN), (const bf16_t*)(ws + OFF_WIN), MT, INW, DM}; pg8::TailSplitOrder S; S.init(MT, INW, DM, G, (int)blockIdx.x);
        EpiProj E{(bf16_t*)(ws + OFF_Q), (bf16_t*)(ws + OFF_KB), (bf16_t*)(ws + OFF_VB), (bf16_t*)(ws + OFF_U), (bf16_t*)(ws + OFF_G), (float*)(ws + OFF_GSS),
                  (const float*)(ws + OFF_ROPE), p.q_norm, p.k_norm, p.out};
        const pg8::SplitCtx sc{(float*)(ws + OFF_WO), 1 << 30, nullptr, (unsigned*)(ws + OFF_BAR + 16384)};
        pg8::gemm_phase(lds, g, S, E, sc);
    SEAM();
    }
#pragma unroll 1
    for (int rep = 0; rep <= REP_P2; ++rep) {
        for (int u = blockIdx.x; u < 256; u += G) { p2_prompt_att(p, lds, u); p2_prompt_sg(p, lds, u); }
        for (int i = blockIdx.x; i < 256; i += G) { if (i < 128) p2_sample_unit(p, lds, i); else p2_sample_sg(p, lds, i - 128); }
        SEAM();
    }
#pragma unroll 1
    for (int rep3 = 0; rep3 <= REP_P3; ++rep3) {
        pg8::Gemm g{(const bf16_t*)(ws + OFF_MIX), (const bf16_t*)(ws + OFF_WO), MT, DM, DM}; pg8::TailSplitOrder S; S.init(MT, DM, DM, G, (int)blockIdx.x, P3_MAXSF);
        EpiWo E{p, (bf16_t*)(ws + OFF_HB), (float*)(ws + OFF_HSS)};
        const pg8::SplitCtx sc{(float*)(ws + OFF_XN), 1 << 30, nullptr, (unsigned*)(ws + OFF_BAR + 16384) + 1024};
        pg8::gemm_phase(lds, g, S, E, sc);
    SEAM();
    }
#pragma unroll 1
    for (int rep4 = 0; rep4 <= REP_P4; ++rep4) {
        pg8::Gemm g{(const bf16_t*)(ws + OFF_HB), (const bf16_t*)(ws + OFF_WGU), MT, 2 * FF, DM}; pg8::TailSplitOrder S; S.init(MT, 2 * FF, DM, G, (int)blockIdx.x, P4_MAXSF);
        EpiGU E{(const float*)(ws + OFF_HSS), (bf16_t*)(ws + OFF_ACT)};
        const pg8::SplitCtx sc{(float*)(ws + OFF_WIN), (int)((OFF_WGU - OFF_WIN) / 262144), (float*)(ws + OFF_MIX), (unsigned*)(ws + OFF_BAR + 16384) + 2048};
        pg8::gemm_phase(lds, g, S, E, sc);
    SEAM();
    }
    {
        pg8::Gemm g{(const bf16_t*)(ws + OFF_ACT), (const bf16_t*)(ws + OFF_WDN), MT, DM, FF}; pg8::TailSplitOrder S; S.init(MT, DM, FF, G, (int)blockIdx.x);
        EpiDown E{p.out, (const bf16_t*)(ws + OFF_HB)};
        const pg8::SplitCtx sc{(float*)(ws + OFF_WIN), 1 << 30, nullptr, (unsigned*)(ws + OFF_BAR + 16384) + 3072};
        pg8::gemm_phase(lds, g, S, E, sc);
    }
}

extern "C" void kernel_launch(void* const* d_in, const int* in_sizes, int n_in, void* d_out, int out_size, void* d_ws, size_t ws_size, hipStream_t stream) {
    static int grid = 0;
    if (grid == 0) {
        if (n_in != 19 || ws_size < WS_END) { fprintf(stderr, "kernel_launch: need 19 inputs and >= %zu bytes of workspace (got %d, %zu)\n", (size_t)WS_END, n_in, ws_size); grid = -1; return; }
        int dev = 0, cus = 0, per_cu = 0;
        hipGetDevice(&dev);
        hipDeviceGetAttribute(&cus, hipDeviceAttributeMultiprocessorCount, dev);
        if (hipFuncSetAttribute((const void*)hymba_fwd, hipFuncAttributeMaxDynamicSharedMemorySize, LDS_BYTES) != hipSuccess) { fprintf(stderr, "kernel_launch: hipFuncSetAttribute failed\n"); grid = -1; return; }
        if (hipOccupancyMaxActiveBlocksPerMultiprocessor(&per_cu, (const void*)hymba_fwd, 512, LDS_BYTES) != hipSuccess || per_cu < 1) { fprintf(stderr, "kernel_launch: occupancy query failed (%d)\n", per_cu); per_cu = 1; }
        (void)hipGetLastError();
        grid = cus * (per_cu > 1 ? 1 : per_cu);
    }
    if (grid < 0) return;
    if (hipMemsetAsync((char*)d_ws + OFF_BAR, 0, BAR_BYTES, stream) != hipSuccess) { fprintf(stderr, "kernel_launch: memset failed\n"); return; }
    Params p{};
    const float** f = (const float**)&p;
    for (int i = 0; i < 19; ++i) f[i] = (const float*)d_in[i];
    p.out = (float*)d_out; p.ws = (unsigned char*)d_ws;
    void* args[] = {&p};
    hipError_t e = hipLaunchCooperativeKernel((const void*)hymba_fwd, dim3(grid), dim3(512), args, LDS_BYTES, stream);
    if (e != hipSuccess) fprintf(stderr, "cooperative launch failed: %s (grid %d)\n", hipGetErrorString(e), grid);
}
```

```cpp
#include <hip/hip_runtime.h>
#include <hip/hip_cooperative_groups.h>
#include <cstdio>
#include <cstdint>
namespace cg = cooperative_groups;

#define LAS __attribute__((address_space(3)))
typedef unsigned short bf16_t;
typedef short bf16x8 __attribute__((ext_vector_type(8)));
typedef short s16x4 __attribute__((ext_vector_type(4)));
typedef float f32x4 __attribute__((ext_vector_type(4)));
typedef unsigned u32x4 __attribute__((ext_vector_type(4)));
typedef unsigned u32x2 __attribute__((ext_vector_type(2)));

constexpr int DM = 2048, MP = 8192, MS = 1024, MT = MP + MS;
constexpr int INW = 3584, FF = 5632, AW = 1024, SGW = 1024, KVW = 256;
constexpr float EPS = 1e-6f;
constexpr int NROPE = 2056;

constexpr size_t OFF_WIN = 0;
constexpr size_t OFF_WO = OFF_WIN + (size_t)INW * DM * 2;
constexpr size_t OFF_WGU = OFF_WO + (size_t)DM * DM * 2;
constexpr size_t OFF_WDN = OFF_WGU + (size_t)2 * FF * DM * 2;
constexpr size_t OFF_HB = OFF_WDN + (size_t)DM * FF * 2;
constexpr size_t OFF_ROPE = OFF_HB + (size_t)MT * DM * 2;
constexpr size_t OFF_WSG = OFF_ROPE + (size_t)NROPE * 64 * 4;
constexpr size_t OFF_GSS = OFF_WSG + (size_t)8 * 128 * 128 * 2;
constexpr size_t OFF_HSS = OFF_GSS + (size_t)MT * 16 * 4;
constexpr size_t OFF_RX = OFF_HSS + (size_t)MT * 32 * 4;
constexpr size_t OFF_BAR = OFF_RX + (size_t)MT * 4;
constexpr size_t BAR_BYTES = 32768;
constexpr size_t OFF_ACT = OFF_BAR + BAR_BYTES;
constexpr size_t OFF_XN = OFF_ACT;
constexpr size_t OFF_Q = OFF_XN + (size_t)MT * DM * 2;
constexpr size_t OFF_KB = OFF_Q + (size_t)MT * AW * 2;
constexpr size_t OFF_VB = OFF_KB + (size_t)MT * KVW * 2;
constexpr size_t OFF_U = OFF_VB + (size_t)MT * KVW * 2;
constexpr size_t OFF_G = OFF_U + (size_t)MT * SGW * 2;
constexpr size_t OFF_MIX = OFF_G + (size_t)MT * SGW * 2;
constexpr size_t WS_END = OFF_MIX + (size_t)152 * 262144;
static_assert(OFF_ACT + (size_t)MT * FF * 2 <= OFF_MIX, "ACT overlay fits");
static_assert((size_t)256 * 262144 <= OFF_WDN && (size_t)128 * 262144 <= OFF_MIX - OFF_Q  , "partial-tile slots overlay only dead buffers");
static_assert(OFF_ACT % 256 == 0 && OFF_ROPE % 256 == 0 && OFF_WSG % 256 == 0, "alignment");

constexpr size_t OUT_Y = 0;
constexpr size_t OUT_KWP = (size_t)MT * DM;
constexpr size_t OUT_VWP = OUT_KWP + 4 * 128 * 256;
constexpr size_t OUT_KWS = OUT_VWP + 4 * 128 * 256;
constexpr size_t OUT_VWS = OUT_KWS + (size_t)128 * 128 * 256;
constexpr size_t OUT_SGV = OUT_VWS + (size_t)128 * 128 * 256;

struct Params {
    const float *x_prompt, *x_sample, *cache_k, *cache_v, *attn_norm, *w_in, *q_norm, *k_norm, *sinks, *sg_norm, *sg_w, *sg_b,
        *attn_out_norm, *sg_out_norm, *w_o, *ffn_norm, *w_gate, *w_up, *w_down;
    float* out; unsigned char* ws;
};

__device__ const double ROPE_INV[32] = {1.0, 0.7498942093324559, 0.5623413251903491, 0.4216965034285822, 0.31622776601683794, 0.23713737056616552, 0.1778279410038923, 0.1333521432163324, 0.1, 0.07498942093324558, 0.05623413251903491, 0.042169650342858224, 0.03162277660168379, 0.023713737056616554, 0.01778279410038923, 0.01333521432163324, 0.01, 0.007498942093324558, 0.005623413251903491, 0.004216965034285823, 0.0031622776601683794, 0.0023713737056616554, 0.0017782794100389228, 0.001333521432163324, 0.001, 0.0007498942093324559, 0.0005623413251903491, 0.00042169650342858224, 0.00031622776601683794, 0.00023713737056616554, 0.00017782794100389227, 0.0001333521432163324};

__device__ __forceinline__ unsigned pk2(float lo, float hi) { unsigned r; asm volatile("v_cvt_pk_bf16_f32 %0, %1, %2" : "=v"(r) : "v"(lo), "v"(hi)); return r; }
__device__ __forceinline__ int opaque(int x) { asm volatile("" : "+v"(x)); return x; }
__device__ __forceinline__ float bf_lo(unsigned w) { return __builtin_bit_cast(float, w << 16); }
__device__ __forceinline__ float bf_hi(unsigned w) { return __builtin_bit_cast(float, w & 0xffff0000u); }
__device__ __forceinline__ float gelu_tanh(float x) {
    const float y = 1.5957691216057308f * (x + 0.044715f * x * x * x);
    return x * __builtin_amdgcn_rcpf(1.0f + __expf(-y));
}
typedef float f32x2 __attribute__((ext_vector_type(2)));
__device__ __forceinline__ f32x2 gelu2(f32x2 x) {
    const f32x2 t = ((x * x) * 0.044715f + 1.0f) * x;
    const f32x2 z = t * (-1.5957691216057308f * 1.4426950408889634f);
    f32x2 e; e.x = __builtin_amdgcn_exp2f(z.x); e.y = __builtin_amdgcn_exp2f(z.y);
    const f32x2 d = e + 1.0f;
    f32x2 r; r.x = __builtin_amdgcn_rcpf(d.x); r.y = __builtin_amdgcn_rcpf(d.y);
    return x * r;
}
__device__ __forceinline__ f32x2 silu_mul2(f32x2 g, f32x2 u) {
    const f32x2 z = g * (-1.4426950408889634f);
    f32x2 e; e.x = __builtin_amdgcn_exp2f(z.x); e.y = __builtin_amdgcn_exp2f(z.y);
    const f32x2 d = e + 1.0f;
    f32x2 r; r.x = __builtin_amdgcn_rcpf(d.x); r.y = __builtin_amdgcn_rcpf(d.y);
    return (g * r) * u;
}
__device__ __forceinline__ float silu(float x) { return x * __builtin_amdgcn_rcpf(1.0f + __expf(-x)); }
__device__ __forceinline__ float wave_sum(float v) {
#pragma unroll
    for (int o = 1; o < 64; o <<= 1) v += __shfl_xor(v, o);
    return v;
}
__device__ __forceinline__ float fq_sum(float v) { v += __shfl_xor(v, 16); v += __shfl_xor(v, 32); return v; }
__device__ __forceinline__ float fq_max(float v) { v = fmaxf(v, __shfl_xor(v, 16)); v = fmaxf(v, __shfl_xor(v, 32)); return v; }
__device__ __forceinline__ const float* xrow(const Params& p, int row) { return row < MP ? p.x_prompt + (size_t)row * DM : p.x_sample + (size_t)(row - MP) * DM; }

namespace pg8 {
constexpr int BM = 256, BK = 64, HALF = 128, HTB = HALF * BK * 2, STAGE_BYTES = 8 * HTB, NXCD = 8, WGM = 8;
__host__ __device__ __forceinline__ int lds_byte(int r, int c) { const int st = (r >> 4) * 2 + (c >> 5), rr = r & 15, cc = c & 31, ob = rr * 64 + cc * 2; return st * 1024 + (ob ^ (((ob >> 9) & 1) << 5)); }
__host__ __device__ __forceinline__ void stage_rc(int b, int& R, int& C) { const int st = b / 1024, sb = b % 1024, swz = sb ^ (((sb >> 9) & 1) << 5); R = (st >> 1) * 16 + swz / 64; C = (st & 1) * 32 + (swz % 64) / 2; }
struct Unit { int pm, pn, kt0, nkt, sq, sj, sf; };
struct Gemm { const bf16_t* A; const bf16_t* Bt; int M, N, K; };
struct TailSplitOrder {
    int nM, nN, nwg, G, c, ntk, nfull, rem, sf;
    __device__ void init(int M, int N, int K, int G_, int c_, int maxsf = 8) {
        nM = M / BM; nN = N / BM; nwg = nM * nN; G = G_; c = c_; ntk = K / BK; nfull = nwg / G; rem = nwg % G;
        sf = rem ? G / rem : 1; if (sf > ntk / 2) sf = ntk / 2; if (sf > maxsf) sf = maxsf; if (sf < 2) sf = 1;
    }
    __device__ void tile(int L, Unit& u) const {
        int wgid = L; { const int q = nwg / NXCD, r = nwg % NXCD, xcd = wgid % NXCD, off = wgid / NXCD; wgid = (xcd < r ? xcd * (q + 1) : r * (q + 1) + (xcd - r) * q) + off; }
        const int nig = WGM * nN, gid = wgid / nig, fm = gid * WGM, gsz = (nM - fm) < WGM ? (nM - fm) : WGM;
        u.pm = fm + ((wgid % nig) % gsz); u.pn = (wgid % nig) / gsz;
    }
    __device__ bool next(int i, Unit& u) const {
        u.kt0 = 0; u.nkt = ntk; u.sq = 0; u.sj = 0; u.sf = 1;
        if (i < nfull) { tile(i * G + c, u); return true; }
        if (i > nfull || rem == 0) return false;
        if (sf == 1) { if (c >= rem) return false; tile(nfull * G + c, u); return true; }
        const int q = c / sf, j = c % sf; if (q >= rem) return false;
        tile(nfull * G + q, u);
        const int pp = ntk / 2, a = pp * j / sf, b = pp * (j + 1) / sf;
        u.kt0 = 2 * a; u.nkt = 2 * (b - a); u.sq = q; u.sj = j; u.sf = sf; return true;
    }
};
struct SplitCtx { float* part0; int n0; float* part1; unsigned* ctr; };
template <class Epi, class Sched>
__device__ __forceinline__ void gemm_phase(LAS unsigned char* lds, const Gemm g, const Sched& S, const Epi& E, const SplitCtx sc) {
    const int tid = opaque(threadIdx.x), wid = __builtin_amdgcn_readfirstlane(tid >> 6), lane = tid & 63, wr = wid >> 2, wc = wid & 3, fr = lane & 15, fq = lane >> 4;
    const int K = g.K;
    unsigned voffA[2];
#pragma unroll
    for (int i = 0; i < 2; ++i) { int R, C; stage_rc(tid * 16 + i * 8192, R, C); voffA[i] = (unsigned)(R * K + C) * 2u; }
    const size_t kstep = (size_t)(BK * 2);
    const size_t hstep = (size_t)HALF * K * 2;
    const size_t tstep = 2 * hstep;
    const unsigned ldsw = (unsigned)wid * 1024u;
    const int aoff = lds_byte(wr * 64 + fr, fq * 8), boff = lds_byte(wc * 32 + fr, fq * 8);
#define PG8_SA(b, h) (((b) * 2 + (h)) * HTB)
#define PG8_SB(b, h) ((4 + (b) * 2 + (h)) * HTB)
#define PG8_STAGE(bufoff, gbase) do { _Pragma("unroll") for (int _i = 0; _i < 2; ++_i) \
        __builtin_amdgcn_global_load_lds((const unsigned*)((const char*)(gbase) + voffA[_i]), (LAS unsigned*)(lds + (bufoff) + ldsw + _i * 8192), 16, 0, 0); } while (0)
#define PG8_LDA(dst, b, h) do { _Pragma("unroll") for (int m = 0; m < 4; ++m) _Pragma("unroll") for (int k = 0; k < 2; ++k) dst[m][k] = *(const LAS bf16x8*)(lds + PG8_SA(b, h) + aoff + m * 2048 + k * 1024); } while (0)
#define PG8_LDB(dst, b, h) do { _Pragma("unroll") for (int n = 0; n < 2; ++n) _Pragma("unroll") for (int k = 0; k < 2; ++k) dst[n][k] = *(const LAS bf16x8*)(lds + PG8_SB(b, h) + boff + n * 2048 + k * 1024); } while (0)
#define PG8_MMA(ai, bj, At, Bt) do { __builtin_amdgcn_s_setprio(1); _Pragma("unroll") for (int m = 0; m < 4; ++m) _Pragma("unroll") for (int n = 0; n < 2; ++n) _Pragma("unroll") for (int k = 0; k < 2; ++k) \
        acc[ai][bj][m][n] = __builtin_amdgcn_mfma_f32_16x16x32_bf16(Bt[n][k], At[m][k], acc[ai][bj][m][n], 0, 0, 0); __builtin_amdgcn_s_setprio(0); } while (0)
#define PG8_WAIT_V(n) asm volatile("s_waitcnt vmcnt(" #n ")" ::: "memory")
#define PG8_WAIT_L(n) asm volatile("s_waitcnt lgkmcnt(" #n ")" ::: "memory")
#define PG8_BAR __builtin_amdgcn_s_barrier()
#define PG8_SCHED __builtin_amdgcn_sched_barrier(0)
    Unit cur, nxt; int ui = 0;
    if (!S.next(0, cur)) return;
    f32x4 acc[2][2][4][2];
#pragma unroll
    for (int a = 0; a < 2; ++a)
#pragma unroll
        for (int b = 0; b < 2; ++b)
#pragma unroll
            for (int m = 0; m < 4; ++m)
#pragma unroll
                for (int n = 0; n < 2; ++n) acc[a][b][m][n] = (f32x4){0.f, 0.f, 0.f, 0.f};
    bf16x8 At[4][2], B0[2][2], B1[2][2];
    const char* cA = (const char*)g.A + (size_t)cur.pm * tstep + (size_t)cur.kt0 * kstep; const char* cB = (const char*)g.Bt + (size_t)cur.pn * tstep + (size_t)cur.kt0 * kstep;
    PG8_STAGE(PG8_SB(0, 0), cB); PG8_STAGE(PG8_SB(0, 1), cB + hstep); PG8_STAGE(PG8_SA(0, 0), cA); PG8_STAGE(PG8_SA(0, 1), cA + hstep);
    if (wr == 1) PG8_BAR;
    PG8_WAIT_V(2); PG8_BAR;
    PG8_STAGE(PG8_SB(1, 0), cB + kstep); PG8_STAGE(PG8_SA(1, 0), cA + kstep); PG8_STAGE(PG8_SB(1, 1), cB + hstep + kstep);
    PG8_WAIT_V(6); PG8_BAR;
    for (;;) {
        const bool has_next = S.next(ui + 1, nxt);
        const char* nA = has_next ? (const char*)g.A + (size_t)nxt.pm * tstep + (size_t)nxt.kt0 * kstep : cA; const char* nB = has_next ? (const char*)g.Bt + (size_t)nxt.pn * tstep + (size_t)nxt.kt0 * kstep : cB;
        const int nt = cur.nkt;
        for (int t = 0; t < nt; t += 2) {
            const bool last = (t == nt - 2);
            const char* a1 = cA + (size_t)(t + 1) * kstep;
            const char* a2 = last ? nA : cA + (size_t)(t + 2) * kstep; const char* b2 = last ? nB : cB + (size_t)(t + 2) * kstep;
            const char* a3 = a2 + kstep; const char* b3 = b2 + kstep;
            PG8_LDB(B0, 0, 0); PG8_LDB(B1, 0, 1); PG8_SCHED; PG8_LDA(At, 0, 0); PG8_STAGE(PG8_SA(1, 1), a1 + hstep);
            PG8_WAIT_V(8); PG8_WAIT_L(0); PG8_BAR; PG8_MMA(0, 0, At, B0); PG8_MMA(0, 1, At, B1); PG8_BAR; PG8_SCHED;
            PG8_LDA(At, 0, 1); PG8_STAGE(PG8_SB(0, 0), b2); PG8_STAGE(PG8_SB(0, 1), b2 + hstep); PG8_STAGE(PG8_SA(0, 0), a2);
            PG8_WAIT_V(8); PG8_WAIT_L(0); PG8_BAR; PG8_MMA(1, 0, At, B0); PG8_MMA(1, 1, At, B1); PG8_BAR; PG8_SCHED;
            PG8_LDB(B0, 1, 0); PG8_LDB(B1, 1, 1); PG8_SCHED; PG8_LDA(At, 1, 0); PG8_STAGE(PG8_SA(0, 1), a2 + hstep);
            PG8_WAIT_V(8); PG8_WAIT_L(0); PG8_BAR; PG8_MMA(0, 0, At, B0); PG8_MMA(0, 1, At, B1); PG8_BAR; PG8_SCHED;
            PG8_LDA(At, 1, 1); PG8_STAGE(PG8_SB(1, 0), b3); PG8_STAGE(PG8_SB(1, 1), b3 + hstep); PG8_STAGE(PG8_SA(1, 0), a3);
            PG8_WAIT_V(8); PG8_WAIT_L(0); PG8_BAR; PG8_MMA(1, 0, At, B0); PG8_MMA(1, 1, At, B1); PG8_BAR; PG8_SCHED;
        }
        if (wr == 0) PG8_BAR;
        int rg0 = 0, rg1 = 8;
        if (cur.sf > 1) {
            {
                const int si = cur.sq * cur.sf + cur.sj;
                u32x4* slot = (u32x4*)((si < sc.n0 ? sc.part0 + (size_t)si * 65536 : sc.part1 + (size_t)(si - sc.n0) * 65536)) + tid;
#pragma unroll
                for (int a = 0; a < 2; ++a)
#pragma unroll
                    for (int m = 0; m < 4; ++m)
#pragma unroll
                        for (int b = 0; b < 2; ++b) {
                            const f32x4 v0 = acc[a][b][m][0], v1 = acc[a][b][m][1];
                            u32x4 w; w.x = pk2(v0[0], v0[1]); w.y = pk2(v0[2], v0[3]); w.z = pk2(v1[0], v1[1]); w.w = pk2(v1[2], v1[3]);
                            *slot = w; slot += 512; asm volatile("" : "+v"(slot));
                        }
            }
            asm volatile("s_waitcnt vmcnt(0)" ::: "memory");
            __syncthreads();
            if (tid == 0) {
                __builtin_amdgcn_fence(__ATOMIC_RELEASE, "agent");
                asm volatile("s_waitcnt vmcnt(0)" ::: "memory");
                unsigned* cw = sc.ctr + 16 * cur.sq;
                (void)__hip_atomic_fetch_add(cw, 1u, __ATOMIC_RELAXED, __HIP_MEMORY_SCOPE_AGENT);
                unsigned sp = 0;
                while (__hip_atomic_load(cw, __ATOMIC_RELAXED, __HIP_MEMORY_SCOPE_AGENT) < (unsigned)cur.sf) { __builtin_amdgcn_s_sleep(1); if (++sp > (1u << 22)) break; }
                __builtin_amdgcn_fence(__ATOMIC_ACQUIRE, "agent");
                asm volatile("s_waitcnt vmcnt(0)" ::: "memory");
            }
            __syncthreads();
            rg0 = 8 * cur.sj / cur.sf; rg1 = 8 * (cur.sj + 1) / cur.sf;
#pragma unroll
            for (int a = 0; a < 2; ++a)
#pragma unroll
                for (int m = 0; m < 4; ++m) {
                    if (a * 4 + m < rg0 || a * 4 + m >= rg1) continue;
                    f32x4 t00 = (f32x4){0.f, 0.f, 0.f, 0.f}, t01 = t00, t10 = t00, t11 = t00;
#pragma unroll 2
                    for (int j = 0; j < cur.sf; ++j) {
                        const int si = cur.sq * cur.sf + j;
                        const u32x4* slot = (const u32x4*)((si < sc.n0 ? sc.part0 + (size_t)si * 65536 : sc.part1 + (size_t)(si - sc.n0) * 65536)) + tid + (size_t)(a * 4 + m) * 1024;
                        const u32x4 w0 = slot[0], w1 = slot[512];
                        t00 += (f32x4){bf_lo(w0.x), bf_hi(w0.x), bf_lo(w0.y), bf_hi(w0.y)}; t01 += (f32x4){bf_lo(w0.z), bf_hi(w0.z), bf_lo(w0.w), bf_hi(w0.w)};
                        t10 += (f32x4){bf_lo(w1.x), bf_hi(w1.x), bf_lo(w1.y), bf_hi(w1.y)}; t11 += (f32x4){bf_lo(w1.z), bf_hi(w1.z), bf_lo(w1.w), bf_hi(w1.w)};
                    }
                    acc[a][0][m][0] = t00; acc[a][0][m][1] = t01; acc[a][1][m][0] = t10; acc[a][1][m][1] = t11;
                }
        }
        E(acc, cur, wr, wc, fr, fq, rg0, rg1);
        if (!has_next) break;
#pragma unroll
        for (int a = 0; a < 2; ++a)
#pragma unroll
            for (int b = 0; b < 2; ++b)
#pragma unroll
                for (int m = 0; m < 4; ++m)
#pragma unroll
                    for (int n = 0; n < 2; ++n) acc[a][b][m][n] = (f32x4){0.f, 0.f, 0.f, 0.f};
        cur = nxt; cA = nA; cB = nB; ++ui;
        if (wr == 1) PG8_BAR;
    }
    PG8_WAIT_V(0);
    PG8_BAR;
#undef PG8_SA
#undef PG8_SB
#undef PG8_STAGE
#undef PG8_LDA
#undef PG8_LDB
#undef PG8_MMA
#undef PG8_WAIT_V
#undef PG8_WAIT_L
#undef PG8_BAR
#undef PG8_SCHED
}
}
using pg8::Unit;

typedef f32x4 Acc[2][2][4][2];

struct EpiProj {
    bf16_t *Q, *Kb, *Vb, *U, *G; float* gss; const float* rope; const float *qn, *kn; float* out;
    __device__ __forceinline__ void operator()(const Acc& acc, const Unit& u, int wr, int wc, int fr, int fq, int rg0, int rg1) const {
        const int pn = u.pn;
        const int rbase = u.pm * 256 + wr * 64 + fr;
        if (pn < 5) {
            const bool isq = pn < 4;
            const float* nw = (isq ? qn : kn) + 8 * fq;
            const f32x4 w00 = *(const f32x4*)(nw), w01 = *(const f32x4*)(nw + 4), w10 = *(const f32x4*)(nw + 32), w11 = *(const f32x4*)(nw + 36);
            const float osc = isq ? 0.125f : 1.0f;
#pragma unroll
            for (int ai = 0; ai < 2; ++ai)
#pragma unroll
                for (int m = 0; m < 4; ++m) {
                if (ai * 4 + m < rg0 || ai * 4 + m >= rg1) continue;
                    if (ai * 4 + m < rg0 || ai * 4 + m >= rg1) continue;
                    const int row = rbase + ai * 128 + m * 16;
                    float ss = 0.f;
#pragma unroll
                    for (int bj = 0; bj < 2; ++bj)
#pragma unroll
                        for (int n = 0; n < 2; ++n) { const f32x4 v = acc[ai][bj][m][n]; ss += (v[0] * v[0] + v[1] * v[1]) + (v[2] * v[2] + v[3] * v[3]); }
                    ss = fq_sum(ss);
                    const float r = rsqrtf(ss * (1.0f / 64.0f) + EPS);
                    const int pidx = row < MP ? (row & 2047) : 2048 + (row & 7);
                    const float* rp = rope + pidx * 64 + 8 * fq;
                    const f32x4 c0 = *(const f32x4*)(rp), c1 = *(const f32x4*)(rp + 4), s0 = *(const f32x4*)(rp + 32), s1 = *(const f32x4*)(rp + 36);
                    const f32x4 x10 = acc[ai][0][m][0] * w00 * r, x11 = acc[ai][0][m][1] * w01 * r, x20 = acc[ai][1][m][0] * w10 * r, x21 = acc[ai][1][m][1] * w11 * r;
                    const f32x4 o10 = (x10 * c0 - x20 * s0) * osc, o11 = (x11 * c1 - x21 * s1) * osc, o20 = (x20 * c0 + x10 * s0) * osc, o21 = (x21 * c1 + x11 * s1) * osc;
                    u32x4 lo, hi;
                    lo.x = pk2(o10[0], o10[1]); lo.y = pk2(o10[2], o10[3]); lo.z = pk2(o11[0], o11[1]); lo.w = pk2(o11[2], o11[3]);
                    hi.x = pk2(o20[0], o20[1]); hi.y = pk2(o20[2], o20[3]); hi.z = pk2(o21[0], o21[1]); hi.w = pk2(o21[2], o21[3]);
                    if (isq) {
                        bf16_t* d = Q + (size_t)row * AW + (4 * pn + wc) * 64 + 8 * fq;
                        *(u32x4*)d = lo; *(u32x4*)(d + 32) = hi;
                    } else {
                        bf16_t* d = Kb + (size_t)row * KVW + wc * 64 + 8 * fq;
                        *(u32x4*)d = lo; *(u32x4*)(d + 32) = hi;
                        float* wdst = nullptr;
                        if (row >= MP) { const int rr = row - MP; wdst = out + OUT_KWS + ((size_t)((rr >> 3) * 128 + 120 + (rr & 7)) * 4 + wc) * 64 + 8 * fq; }
                        else if ((row & 2047) >= 1920) wdst = out + OUT_KWP + ((size_t)((row >> 11) * 128 + (row & 2047) - 1920) * 4 + wc) * 64 + 8 * fq;
                        if (wdst) { *(f32x4*)wdst = o10; *(f32x4*)(wdst + 4) = o11; *(f32x4*)(wdst + 32) = o20; *(f32x4*)(wdst + 36) = o21; }
                    }
                }
        } else if (pn == 5) {
#pragma unroll
            for (int ai = 0; ai < 2; ++ai)
#pragma unroll
                for (int m = 0; m < 4; ++m) {
                if (ai * 4 + m < rg0 || ai * 4 + m >= rg1) continue;
                    if (ai * 4 + m < rg0 || ai * 4 + m >= rg1) continue;
                    const int row = rbase + ai * 128 + m * 16;
                    float* wdst = nullptr;
                    if (row >= MP) { const int rr = row - MP; wdst = out + OUT_VWS + ((size_t)((rr >> 3) * 128 + 120 + (rr & 7)) * 4 + wc) * 64 + 8 * fq; }
                    else if ((row & 2047) >= 1920) wdst = out + OUT_VWP + ((size_t)((row >> 11) * 128 + (row & 2047) - 1920) * 4 + wc) * 64 + 8 * fq;
#pragma unroll
                    for (int bj = 0; bj < 2; ++bj) {
                        const f32x4 v0 = acc[ai][bj][m][0], v1 = acc[ai][bj][m][1];
                        u32x4 w; w.x = pk2(v0[0], v0[1]); w.y = pk2(v0[2], v0[3]); w.z = pk2(v1[0], v1[1]); w.w = pk2(v1[2], v1[3]);
                        *(u32x4*)(Vb + (size_t)row * KVW + wc * 64 + 32 * bj + 8 * fq) = w;
                        if (wdst) { *(f32x4*)(wdst + 32 * bj) = v0; *(f32x4*)(wdst + 32 * bj + 4) = v1; }
                    }
                }
        } else {
            const bool isg = pn >= 10;
            bf16_t* dst = isg ? G : U; const int ct = isg ? pn - 10 : pn - 6;
#pragma unroll
            for (int ai = 0; ai < 2; ++ai)
#pragma unroll
                for (int m = 0; m < 4; ++m) {
                if (ai * 4 + m < rg0 || ai * 4 + m >= rg1) continue;
                    if (ai * 4 + m < rg0 || ai * 4 + m >= rg1) continue;
                    const int row = rbase + ai * 128 + m * 16;
                    float ss = 0.f;
#pragma unroll
                    for (int bj = 0; bj < 2; ++bj) {
                        f32x4 v0 = acc[ai][bj][m][0], v1 = acc[ai][bj][m][1];
                        { const f32x2 a = gelu2((f32x2){v0[0], v0[1]}), b2 = gelu2((f32x2){v0[2], v0[3]}), c2 = gelu2((f32x2){v1[0], v1[1]}), d2 = gelu2((f32x2){v1[2], v1[3]});
                          v0 = (f32x4){a.x, a.y, b2.x, b2.y}; v1 = (f32x4){c2.x, c2.y, d2.x, d2.y}; }
                        ss += (v0[0] * v0[0] + v0[1] * v0[1]) + (v0[2] * v0[2] + v0[3] * v0[3]) + (v1[0] * v1[0] + v1[1] * v1[1]) + (v1[2] * v1[2] + v1[3] * v1[3]);
                        u32x4 w; w.x = pk2(v0[0], v0[1]); w.y = pk2(v0[2], v0[3]); w.z = pk2(v1[0], v1[1]); w.w = pk2(v1[2], v1[3]);
                        *(u32x4*)(dst + (size_t)row * SGW + ct * 256 + wc * 64 + 32 * bj + 8 * fq) = w;
                    }
                    if (isg) { ss = fq_sum(ss); if (fq == 0) gss[(size_t)row * 16 + ct * 4 + wc] = ss; }
                }
        }
    }
};

struct EpiWo {
    Params p; bf16_t* HB; float* hss; const bf16_t* XN; const float* rx;
    __device__ __forceinline__ void operator()(const Acc& acc, const Unit& u, int wr, int wc, int fr, int fq, int rg0, int rg1) const {
        const int rbase = u.pm * 256 + wr * 64 + fr, cb = u.pn * 256 + wc * 64 + 8 * fq;
        f32x4 gi[2][2];
#pragma unroll
        for (int bj = 0; bj < 2; ++bj)
#pragma unroll
            for (int n = 0; n < 2; ++n) { const f32x4 g = *(const f32x4*)(p.attn_norm + cb + 32 * bj + 4 * n);
                gi[bj][n] = (f32x4){__builtin_amdgcn_rcpf(g[0]), __builtin_amdgcn_rcpf(g[1]), __builtin_amdgcn_rcpf(g[2]), __builtin_amdgcn_rcpf(g[3])}; }
#pragma unroll
        for (int ai = 0; ai < 2; ++ai)
#pragma unroll
        for (int mh = 0; mh < 2; ++mh) {
            u32x4 xv[4][2]; float ri[4];
#pragma unroll
            for (int m = 2 * mh; m < 2 * mh + 2; ++m) {
                if (ai * 4 + m < rg0 || ai * 4 + m >= rg1) continue;
                const int row = rbase + ai * 128 + m * 16;
                ri[m] = rx[row];
#pragma unroll
                for (int bj = 0; bj < 2; ++bj) xv[m][bj] = *(const u32x4*)(XN + (size_t)row * DM + cb + 32 * bj);
            }
#pragma unroll
            for (int m = 2 * mh; m < 2 * mh + 2; ++m) {
                if (ai * 4 + m < rg0 || ai * 4 + m >= rg1) continue;
                const int row = rbase + ai * 128 + m * 16;
                const float rinv = __builtin_amdgcn_rcpf(ri[m]);
                float ss = 0.f;
#pragma unroll
                for (int bj = 0; bj < 2; ++bj) {
                    const u32x4 w0 = xv[m][bj];
                    const f32x4 x0 = (f32x4){bf_lo(w0.x), bf_hi(w0.x), bf_lo(w0.y), bf_hi(w0.y)} * gi[bj][0] * rinv, x1 = (f32x4){bf_lo(w0.z), bf_hi(w0.z), bf_lo(w0.w), bf_hi(w0.w)} * gi[bj][1] * rinv;
                    const f32x4 h0 = x0 + acc[ai][bj][m][0], h1 = x1 + acc[ai][bj][m][1];
                    ss += (h0[0] * h0[0] + h0[1] * h0[1]) + (h0[2] * h0[2] + h0[3] * h0[3]) + (h1[0] * h1[0] + h1[1] * h1[1]) + (h1[2] * h1[2] + h1[3] * h1[3]);
                    u32x4 w; w.x = pk2(h0[0], h0[1]); w.y = pk2(h0[2], h0[3]); w.z = pk2(h1[0], h1[1]); w.w = pk2(h1[2], h1[3]);
                    *(u32x4*)(HB + (size_t)row * DM + cb + 32 * bj) = w;
                }
                ss = fq_sum(ss);
                if (fq == 0) hss[(size_t)row * 32 + u.pn * 4 + wc] = ss;
            }
        }
    }
};

struct EpiGU {
    const float* hss; bf16_t* ACT;
    __device__ __forceinline__ void operator()(const Acc& acc, const Unit& u, int wr, int wc, int fr, int fq, int rg0, int rg1) const {
        const int rbase = u.pm * 256 + wr * 64 + fr, cb = u.pn * 128 + wc * 32 + 8 * fq;
        float r8[8];
#pragma unroll
        for (int ai = 0; ai < 2; ++ai)
#pragma unroll
            for (int m = 0; m < 4; ++m) {
                r8[ai * 4 + m] = 0.f;
                if (ai * 4 + m < rg0 || ai * 4 + m >= rg1) continue;
                const f32x4* hp = (const f32x4*)(hss + (size_t)(rbase + ai * 128 + m * 16) * 32) + 2 * fq;
                const f32x4 t = hp[0] + hp[1];
                r8[ai * 4 + m] = (t[0] + t[1]) + (t[2] + t[3]);
            }
#pragma unroll
        for (int ai = 0; ai < 2; ++ai)
#pragma unroll
            for (int m = 0; m < 4; ++m) {
                if (ai * 4 + m < rg0 || ai * 4 + m >= rg1) continue;
                const int row = rbase + ai * 128 + m * 16;
                const float r = rsqrtf(fq_sum(r8[ai * 4 + m]) * (1.0f / DM) + EPS);
                const f32x4 g0 = acc[ai][0][m][0] * r, g1 = acc[ai][0][m][1] * r, u0 = acc[ai][1][m][0] * r, u1 = acc[ai][1][m][1] * r;
                const f32x2 p0 = silu_mul2((f32x2){g0[0], g0[1]}, (f32x2){u0[0], u0[1]}), p1 = silu_mul2((f32x2){g0[2], g0[3]}, (f32x2){u0[2], u0[3]});
                const f32x2 p2 = silu_mul2((f32x2){g1[0], g1[1]}, (f32x2){u1[0], u1[1]}), p3 = silu_mul2((f32x2){g1[2], g1[3]}, (f32x2){u1[2], u1[3]});
                const f32x4 a0 = (f32x4){p0.x, p0.y, p1.x, p1.y}, a1 = (f32x4){p2.x, p2.y, p3.x, p3.y};
                u32x4 w; w.x = pk2(a0[0], a0[1]); w.y = pk2(a0[2], a0[3]); w.z = pk2(a1[0], a1[1]); w.w = pk2(a1[2], a1[3]);
                *(u32x4*)(ACT + (size_t)row * FF + cb) = w;
            }
    }
};

struct EpiDown {
    float* out; const bf16_t* HB;
    __device__ __forceinline__ void operator()(const Acc& acc, const Unit& u, int wr, int wc, int fr, int fq, int rg0, int rg1) const {
        const int rbase = u.pm * 256 + wr * 64 + fr, cb = u.pn * 256 + wc * 64 + 8 * fq;
#pragma unroll
        for (int ai = 0; ai < 2; ++ai) {
            u32x4 hv[4][2];
#pragma unroll
            for (int m = 0; m < 4; ++m) {
                if (ai * 4 + m < rg0 || ai * 4 + m >= rg1) continue;
                const bf16_t* hr = HB + (size_t)(rbase + ai * 128 + m * 16) * DM + cb;
#pragma unroll
                for (int bj = 0; bj < 2; ++bj) hv[m][bj] = *(const u32x4*)(hr + 32 * bj);
            }
#pragma unroll
            for (int m = 0; m < 4; ++m) {
                if (ai * 4 + m < rg0 || ai * 4 + m >= rg1) continue;
                float* yr = out + OUT_Y + (size_t)(rbase + ai * 128 + m * 16) * DM + cb;
#pragma unroll
                for (int bj = 0; bj < 2; ++bj) {
                    const u32x4 w = hv[m][bj];
                    const f32x4 h0 = (f32x4){bf_lo(w.x), bf_hi(w.x), bf_lo(w.y), bf_hi(w.y)}, h1 = (f32x4){bf_lo(w.z), bf_hi(w.z), bf_lo(w.w), bf_hi(w.w)};
                    __builtin_nontemporal_store(h0 + acc[ai][bj][m][0], (f32x4*)(yr + 32 * bj)); __builtin_nontemporal_store(h1 + acc[ai][bj][m][1], (f32x4*)(yr + 32 * bj + 4));
                }
            }
        }
    }
};

__device__ __forceinline__ void p0_transpose_item(const float* W, int K, int N, bf16_t* WT, int mode, const float* s0, const float* s1, int split,
                                                  LAS float* scr, int item, int lane) {
    const int nblk = N / 32, kb = item / nblk, nb = item % nblk, k0 = 64 * kb, n0 = 32 * nb;
#pragma unroll 8
    for (int i = 0; i < 32; ++i) { const int kk = 2 * i + (lane >> 5); scr[kk * 33 + (lane & 31)] = __builtin_nontemporal_load(W + (size_t)(k0 + kk) * N + n0 + (lane & 31)); }
    asm volatile("s_waitcnt lgkmcnt(0)" ::: "memory");
    const int c = lane & 7;
    float sc[8];
#pragma unroll
    for (int e = 0; e < 8; ++e) { const int k = k0 + 8 * c + e; sc[e] = s0 ? (k < split ? s0[k] : s1[k - split]) : 1.0f; }
    int rowbase;
    if (mode == 0) rowbase = (n0 >> 8) * 256 + ((n0 >> 5) & 1) * 128 + ((n0 >> 6) & 3) * 32;
    else rowbase = (n0 >> 7) * 256 + (mode - 1) * 128 + ((n0 >> 5) & 3) * 32;
#pragma unroll
    for (int j = 0; j < 4; ++j) {
        const int n = (lane >> 3) + 8 * j; const LAS float* s = scr + (8 * c) * 33 + n;
        const int pr = 16 * ((n >> 2) & 1) + 4 * (n >> 3) + (n & 3);
        u32x4 o; o.x = pk2(s[0 * 33] * sc[0], s[1 * 33] * sc[1]); o.y = pk2(s[2 * 33] * sc[2], s[3 * 33] * sc[3]); o.z = pk2(s[4 * 33] * sc[4], s[5 * 33] * sc[5]); o.w = pk2(s[6 * 33] * sc[6], s[7 * 33] * sc[7]);
        *(u32x4*)(WT + (size_t)(rowbase + pr) * K + k0 + 8 * c) = o;
    }
    asm volatile("s_waitcnt lgkmcnt(0)" ::: "memory");
}

__device__ __forceinline__ void sincos_pi(double r, double& s, double& c) {
    const double x2 = r * r;
    double ps = -1.0 / 1.0888869450418352e28;
    ps = ps * x2 + 1.0 / 1.5511210043330986e25;
    ps = ps * x2 - 1.0 / 2.585201673888498e22;
    ps = ps * x2 + 1.0 / 5.109094217170944e19;
    ps = ps * x2 - 1.0 / 1.21645100408832e17;
    ps = ps * x2 + 1.0 / 3.55687428096e14;
    ps = ps * x2 - 1.0 / 1.307674368e12;
    ps = ps * x2 + 1.0 / 6.2270208e9;
    ps = ps * x2 - 1.0 / 3.99168e7;
    ps = ps * x2 + 1.0 / 362880.0;
    ps = ps * x2 - 1.0 / 5040.0;
    ps = ps * x2 + 1.0 / 120.0;
    ps = ps * x2 - 1.0 / 6.0;
    ps = ps * x2 + 1.0;
    s = ps * r;
    double pc = -1.0 / 4.0329146112660565e26;
    pc = pc * x2 + 1.0 / 6.204484017332394e23;
    pc = pc * x2 - 1.0 / 1.1240007277776077e21;
    pc = pc * x2 + 1.0 / 2.43290200817664e18;
    pc = pc * x2 - 1.0 / 6.402373705728e15;
    pc = pc * x2 + 1.0 / 2.0922789888e13;
    pc = pc * x2 - 1.0 / 8.71782912e10;
    pc = pc * x2 + 1.0 / 4.790016e8;
    pc = pc * x2 - 1.0 / 3628800.0;
    pc = pc * x2 + 1.0 / 40320.0;
    pc = pc * x2 - 1.0 / 720.0;
    pc = pc * x2 + 1.0 / 24.0;
    pc = pc * x2 - 0.5;
    pc = pc * x2 + 1.0;
    c = pc;
}

__device__ __forceinline__ void p0_prologue(const Params& p, LAS unsigned char* lds) {
    const int tid = opaque(threadIdx.x), lane = tid & 63, wave = __builtin_amdgcn_readfirstlane(tid >> 6);
    unsigned char* ws = p.ws;
    const int G = gridDim.x, gw = blockIdx.x * 8 + wave, NGW = G * 8;
    LAS float* scr = (LAS float*)(lds + wave * 16384);
    constexpr int I_IN = (DM / 64) * (INW / 32), I_O = (DM / 64) * (DM / 32), I_G = (DM / 64) * (FF / 32), I_D = (FF / 64) * (DM / 32);
    constexpr int NITEMS = I_IN + I_O + 2 * I_G + I_D;
    for (int it = gw; it < NITEMS; it += NGW) {
        int r = it;
        if (r < I_IN) { p0_transpose_item(p.w_in, DM, INW, (bf16_t*)(ws + OFF_WIN), 0, nullptr, nullptr, 0, scr, r, lane); continue; } r -= I_IN;
        if (r < I_O) { p0_transpose_item(p.w_o, DM, DM, (bf16_t*)(ws + OFF_WO), 0, p.attn_out_norm, p.sg_out_norm, AW, scr, r, lane); continue; } r -= I_O;
        if (r < I_G) { p0_transpose_item(p.w_gate, DM, FF, (bf16_t*)(ws + OFF_WGU), 1, p.ffn_norm, p.ffn_norm, DM, scr, r, lane); continue; } r -= I_G;
        if (r < I_G) { p0_transpose_item(p.w_up, DM, FF, (bf16_t*)(ws + OFF_WGU), 2, p.ffn_norm, p.ffn_norm, DM, scr, r, lane); continue; } r -= I_G;
        p0_transpose_item(p.w_down, FF, DM, (bf16_t*)(ws + OFF_WDN), 0, nullptr, nullptr, 0, scr, r, lane);
    }
    bf16_t* XN = (bf16_t*)(ws + OFF_XN);
    for (int m = gw; m < MT; m += NGW) {
        const f32x4* xr = (const f32x4*)xrow(p, m) + lane;
        f32x4 v[8]; float s = 0.f;
#pragma unroll
        for (int j = 0; j < 8; ++j) { v[j] = xr[64 * j]; s += (v[j][0] * v[j][0] + v[j][1] * v[j][1]) + (v[j][2] * v[j][2] + v[j][3] * v[j][3]); }
        const float r = rsqrtf(wave_sum(s) * (1.0f / DM) + EPS);
        if (lane == 0) ((float*)(ws + OFF_RX))[m] = r;
        u32x2* o8 = (u32x2*)(XN + (size_t)m * DM) + lane;
#pragma unroll
        for (int j = 0; j < 8; ++j) { const f32x4 w = ((const f32x4*)p.attn_norm)[lane + 64 * j]; const f32x4 y = v[j] * r * w; u32x2 o; o.x = pk2(y[0], y[1]); o.y = pk2(y[2], y[3]); o8[64 * j] = o; }
    }
    const int gt = blockIdx.x * 512 + tid, NT = G * 512;
    float* rope = (float*)(ws + OFF_ROPE);
    for (int e = gt; e < NROPE * 32; e += NT) {
        const int pi = e >> 5, i = e & 31;
        const double pos = pi < 2048 ? (double)pi : (double)(16384 + pi - 2048);
        const double a = pos * ROPE_INV[i];
        const double k = __builtin_rint(a * 0.15915494309189535);
        double r = __builtin_fma(-k, 6.283185307179586, a); r = __builtin_fma(-k, 2.4492935982947064e-16, r);
        double s, c; sincos_pi(r, s, c);
        rope[pi * 64 + i] = (float)c; rope[pi * 64 + 32 + i] = (float)s;
    }
    bf16_t* wsg = (bf16_t*)(ws + OFF_WSG);
    for (int e = gt; e < 8 * 128 * 128 / 2; e += NT) {
        const int idx = 2 * e, j = idx & 127, i = (idx >> 7) & 127;
        const float a = j <= i ? p.sg_w[idx] : 0.f, b = (j + 1) <= i ? p.sg_w[idx + 1] : 0.f;
        ((unsigned*)wsg)[e] = pk2(a, b);
    }
}

constexpr int KROW = 144;
constexpr int KVH_BYTES = 160 * KROW;
constexpr int GROW = 544;
constexpr int L_K = 0, L_V = 2 * KVH_BYTES, L_RED = 4 * KVH_BYTES  , L_RG = L_RED + 32 * 8 * 4;
constexpr int GBUF = 128 * GROW  , L_RED2 = 2 * GBUF  , L_RG2 = L_RED2 + 32 * 8 * 4;

__device__ __forceinline__ s16x4 ldtr(const LAS unsigned char* p) { return __builtin_bit_cast(s16x4, __builtin_amdgcn_ds_read_tr16_b64_v4i16((LAS s16x4*)p)); }

template <int NQB>
__device__ __forceinline__ void attn_core(const LAS unsigned char* Kl, const LAS unsigned char* Vl, const bf16x8 (&qf)[NQB][2], float sink, int kmin,
                                          f32x4 (&o)[NQB][4], int lane) {
    const int fr = lane & 15, fq = lane >> 4, tq = (lane & 15) >> 2, tp = lane & 3;
#pragma unroll
    for (int qb = 0; qb < NQB; ++qb) {
        asm volatile("" ::: "memory");
        const int qi = 16 * qb + fr;
        const bf16x8 q0 = qf[qb][0], q1 = qf[qb][1];
        f32x4 s[10];
#pragma unroll
        for (int t = 0; t < 10; ++t) {
            const LAS unsigned char* kp = Kl + (16 * t + fr) * KROW + 16 * fq;
            const bf16x8 k0 = *(const LAS bf16x8*)kp, k1 = *(const LAS bf16x8*)(kp + 64);
            s[t] = __builtin_amdgcn_mfma_f32_16x16x32_bf16(k0, q0, (f32x4){0.f, 0.f, 0.f, 0.f}, 0, 0, 0);
            s[t] = __builtin_amdgcn_mfma_f32_16x16x32_bf16(k1, q1, s[t], 0, 0, 0);
            if (t & 1) __builtin_amdgcn_sched_barrier(0);
        }
        float mx = -INFINITY;
#pragma unroll
        for (int t = 0; t < 10; ++t)
#pragma unroll
            for (int j = 0; j < 4; ++j) {
                const int kj = 16 * t + 4 * fq + j, diff = 128 + qi - kj;
                const bool valid = (diff >= 0) && (diff < 128) && (kj >= kmin);
                s[t][j] = valid ? s[t][j] : -INFINITY;
                mx = fmaxf(mx, s[t][j]);
            }
        mx = fmaxf(fq_max(mx), sink);
        float sum = 0.f;
#pragma unroll
        for (int t = 0; t < 10; ++t)
#pragma unroll
            for (int j = 0; j < 4; ++j) { const float e = __expf(s[t][j] - mx); s[t][j] = e; sum += e; }
        sum = fq_sum(sum) + __expf(sink - mx);
        const float inv = 1.0f / sum;
#pragma unroll
        for (int dt = 0; dt < 4; ++dt) o[qb][dt] = (f32x4){0.f, 0.f, 0.f, 0.f};
#pragma unroll
        for (int T = 0; T < 5; ++T) {
            u32x4 pw; pw.x = pk2(s[2 * T][0] * inv, s[2 * T][1] * inv); pw.y = pk2(s[2 * T][2] * inv, s[2 * T][3] * inv);
            pw.z = pk2(s[2 * T + 1][0] * inv, s[2 * T + 1][1] * inv); pw.w = pk2(s[2 * T + 1][2] * inv, s[2 * T + 1][3] * inv);
            const bf16x8 pf = __builtin_bit_cast(bf16x8, pw);
            const LAS unsigned char* vp = Vl + (32 * T + 4 * fq + tq) * KROW + 8 * tp;
#pragma unroll
            for (int dt = 0; dt < 4; ++dt) {
                const s16x4 lo = ldtr(vp + 32 * dt), hi = ldtr(vp + 16 * KROW + 32 * dt);
                const bf16x8 vf = __builtin_shufflevector(lo, hi, 0, 1, 2, 3, 4, 5, 6, 7);
                o[qb][dt] = __builtin_amdgcn_mfma_f32_16x16x32_bf16(vf, pf, o[qb][dt], 0, 0, 0);
            }
            __builtin_amdgcn_sched_barrier(0);
        }
    }
}

template <int NQB>
__device__ __forceinline__ void load_q(bf16x8 (&qf)[NQB][2], const bf16_t* Qg  , int nq, int lane) {
    const int fr = lane & 15, fq = lane >> 4;
#pragma unroll
    for (int qb = 0; qb < NQB; ++qb) {
        const int qi = 16 * qb + fr, qic = qi < nq ? qi : nq - 1;
        const bf16_t* qp = Qg + (size_t)qic * AW + 8 * fq;
        qf[qb][0] = *(const bf16x8*)qp; qf[qb][1] = *(const bf16x8*)(qp + 32);
    }
}
__device__ __forceinline__ float rowscale16(const float* ss16) {
    const f32x4* q = (const f32x4*)ss16; const f32x4 t = (q[0] + q[1]) + (q[2] + q[3]);
    return rsqrtf(((t[0] + t[1]) + (t[2] + t[3])) * (1.0f / 1024.0f) + EPS);
}

__device__ __forceinline__ void p2_prompt_att(const Params& p, LAS unsigned char* lds, int unit) {
    const int tid = opaque(threadIdx.x), lane = tid & 63, wave = __builtin_amdgcn_readfirstlane(tid >> 6);
    unsigned char* ws = p.ws;
    const bf16_t* Q = (const bf16_t*)(ws + OFF_Q); const bf16_t* Kb = (const bf16_t*)(ws + OFF_KB); const bf16_t* Vb = (const bf16_t*)(ws + OFF_VB);
    const bf16_t* U = (const bf16_t*)(ws + OFF_U); const bf16_t* Gm = (const bf16_t*)(ws + OFF_G); bf16_t* MIX = (bf16_t*)(ws + OFF_MIX);
    const float* gss = (const float*)(ws + OFF_GSS); const bf16_t* wsg = (const bf16_t*)(ws + OFF_WSG);
    const int b = unit >> 6, s0 = (unit & 63) * 32, row0 = b * 2048 + s0;
    const int fr = lane & 15, fq = lane >> 4, tq = (lane & 15) >> 2, tp = lane & 3;
    LAS float* red = (LAS float*)(lds + L_RED);
    LAS float* rgl = (LAS float*)(lds + L_RG);
    {
        f32x4 o[2][2][4];
        const int kmin = s0 < 128 ? 128 - s0 : 0;
        u32x4 kr[5], vr[5];
#define ATT_LOADKV(ps_) do { _Pragma("unroll") for (int it = 0; it < 5; ++it) { const int c_ = tid + 512 * it, kj_ = c_ >> 4, ch_ = c_ & 15, kp_ = s0 - 128 + kj_; \
            kr[it] = (u32x4){0u, 0u, 0u, 0u}; vr[it] = kr[it]; \
            if (kp_ >= 0) { const size_t g_ = (size_t)(b * 2048 + kp_) * KVW + 128 * (ps_) + ch_ * 8; kr[it] = *(const u32x4*)(Kb + g_); vr[it] = *(const u32x4*)(Vb + g_); } } } while (0)
#define ATT_STOREKV() do { _Pragma("unroll") for (int it = 0; it < 5; ++it) { const int c_ = tid + 512 * it, kj_ = c_ >> 4, ch_ = c_ & 15; \
            const int off_ = ((ch_ >> 3) * 160 + kj_) * KROW + (ch_ & 7) * 16; *(LAS u32x4*)(lds + L_K + off_) = kr[it]; *(LAS u32x4*)(lds + L_V + off_) = vr[it]; } } while (0)
        bf16x8 qf[2][2];
        ATT_LOADKV(0);
        load_q<2>(qf, Q + (size_t)row0 * AW + wave * 64, 32, lane);
        const float sink0 = p.sinks[wave], sink1 = p.sinks[8 + wave];
        ATT_STOREKV();
        __syncthreads();
        ATT_LOADKV(1);
        attn_core<2>(lds + L_K + (wave >> 2) * KVH_BYTES, lds + L_V + (wave >> 2) * KVH_BYTES, qf, sink0, kmin, o[0], lane);
        load_q<2>(qf, Q + (size_t)row0 * AW + (8 + wave) * 64, 32, lane);
        __syncthreads();
        ATT_STOREKV();
        __syncthreads();
        attn_core<2>(lds + L_K + (wave >> 2) * KVH_BYTES, lds + L_V + (wave >> 2) * KVH_BYTES, qf, sink1, kmin, o[1], lane);
#undef ATT_LOADKV
#undef ATT_STOREKV
#pragma unroll
        for (int qb = 0; qb < 2; ++qb) {
            float ss = 0.f;
#pragma unroll
            for (int ps = 0; ps < 2; ++ps)
#pragma unroll
                for (int dt = 0; dt < 4; ++dt) { const f32x4 v = o[ps][qb][dt]; ss += (v[0] * v[0] + v[1] * v[1]) + (v[2] * v[2] + v[3] * v[3]); }
            ss = fq_sum(ss);
            if (fq == 0) red[(16 * qb + fr) * 8 + wave] = ss;
        }
        __syncthreads();
#pragma unroll
        for (int qb = 0; qb < 2; ++qb) {
            const LAS f32x4* rr = (const LAS f32x4*)(red + (16 * qb + fr) * 8); const f32x4 t = rr[0] + rr[1];
            const float ra = rsqrtf(((t[0] + t[1]) + (t[2] + t[3])) * (1.0f / 1024.0f) + EPS);
#pragma unroll
            for (int ps = 0; ps < 2; ++ps)
#pragma unroll
                for (int dt = 0; dt < 4; ++dt) {
                    const f32x4 v = o[ps][qb][dt] * ra; u32x2 w; w.x = pk2(v[0], v[1]); w.y = pk2(v[2], v[3]);
                    *(u32x2*)(MIX + (size_t)(row0 + 16 * qb + fr) * DM + (8 * ps + wave) * 64 + 16 * dt + 4 * fq) = w;
                }
        }
        __syncthreads();
    }
}
__device__ __forceinline__ void p2_prompt_sg(const Params& p, LAS unsigned char* lds, int unit) {
    const int tid = opaque(threadIdx.x), lane = tid & 63, wave = __builtin_amdgcn_readfirstlane(tid >> 6);
    unsigned char* ws = p.ws;
    const bf16_t* U = (const bf16_t*)(ws + OFF_U); const bf16_t* Gm = (const bf16_t*)(ws + OFF_G); bf16_t* MIX = (bf16_t*)(ws + OFF_MIX);
    const float* gss = (const float*)(ws + OFF_GSS); const bf16_t* wsg = (const bf16_t*)(ws + OFF_WSG);
    const int b = unit >> 6, s0 = (unit & 63) * 32, row0 = b * 2048 + s0;
    const int fr = lane & 15, fq = lane >> 4, tq = (lane & 15) >> 2, tp = lane & 3;
    LAS float* red = (LAS float*)(lds + L_RED2);
    LAS float* rgl = (LAS float*)(lds + L_RG2);
    {
        const int c = (s0 >> 5) & 3, crow0 = b * 2048 + (s0 & ~127), nrows = 32 * (c + 1), nk = 2 * (c + 1);
        const int sj = tid >> 5, sch = tid & 31;
        u32x4 gv[8]; f32x4 gn0, gn1;
#define SG_LOADG(ps_) do { _Pragma("unroll") for (int k = 0; k < 8; ++k) if (k < nk) gv[k] = *(const u32x4*)(Gm + (size_t)(crow0 + sj + 16 * k) * SGW + 256 * (ps_) + 8 * sch); \
            gn0 = *(const f32x4*)(p.sg_norm + 256 * (ps_) + 8 * sch); gn1 = *(const f32x4*)(p.sg_norm + 256 * (ps_) + 8 * sch + 4); } while (0)
#define SG_STOREG(buf_) do { _Pragma("unroll") for (int k = 0; k < 8; ++k) if (k < nk) { const float r_ = rgl[sj + 16 * k]; const f32x4 n0_ = gn0 * r_, n1_ = gn1 * r_; const u32x4 g_ = gv[k]; u32x4 w_; \
            w_.x = pk2(bf_lo(g_.x) * n0_[0], bf_hi(g_.x) * n0_[1]); w_.y = pk2(bf_lo(g_.y) * n0_[2], bf_hi(g_.y) * n0_[3]); \
            w_.z = pk2(bf_lo(g_.z) * n1_[0], bf_hi(g_.z) * n1_[1]); w_.w = pk2(bf_lo(g_.w) * n1_[2], bf_hi(g_.w) * n1_[3]); \
            *(LAS u32x4*)(lds + (buf_) * GBUF + (sj + 16 * k) * GROW + sch * 16) = w_; } } while (0)
        SG_LOADG(0);
        if (tid < nrows) rgl[tid] = rowscale16(gss + (size_t)(crow0 + tid) * 16);
        __syncthreads();
        SG_STOREG(0);
        __syncthreads();
        f32x4 sg[4][2][2];
#pragma unroll
        for (int ps = 0; ps < 4; ++ps) {
            const int hl = wave >> 2, head = 2 * ps + hl, dq = wave & 3;
            if (ps < 3) SG_LOADG(ps + 1);
            bf16x8 wf[4][2]; u32x2 uv[2][2]; float bias[2];
#pragma unroll
            for (int J = 0; J < 4; ++J)
                if (J <= c) {
#pragma unroll
                    for (int ib = 0; ib < 2; ++ib) wf[J][ib] = *(const bf16x8*)(wsg + ((size_t)(head * 128 + 32 * c + 16 * ib + fr) * 128 + 32 * J + 8 * fq));
                }
#pragma unroll
            for (int ib = 0; ib < 2; ++ib) {
                bias[ib] = p.sg_b[head * 128 + 32 * c + 16 * ib + fr];
#pragma unroll
                for (int dt = 0; dt < 2; ++dt) uv[ib][dt] = *(const u32x2*)(U + (size_t)(row0 + 16 * ib + fr) * SGW + head * 128 + 32 * dq + 16 * dt + 4 * fq);
            }
            f32x4 a[2][2];
#pragma unroll
            for (int ib = 0; ib < 2; ++ib)
#pragma unroll
                for (int dt = 0; dt < 2; ++dt) a[ib][dt] = (f32x4){0.f, 0.f, 0.f, 0.f};
#pragma unroll
            for (int J = 0; J < 4; ++J)
                if (J <= c) {
                    const LAS unsigned char* gp = lds + (ps & 1) * GBUF + (32 * J + 8 * fq + tq) * GROW + (128 * hl + 32 * dq + 4 * tp) * 2;
#pragma unroll
                    for (int dt = 0; dt < 2; ++dt) {
                        const s16x4 lo = ldtr(gp + 32 * dt), hi = ldtr(gp + 4 * GROW + 32 * dt);
                        const bf16x8 gf = __builtin_shufflevector(lo, hi, 0, 1, 2, 3, 4, 5, 6, 7);
#pragma unroll
                        for (int ib = 0; ib < 2; ++ib) a[ib][dt] = __builtin_amdgcn_mfma_f32_16x16x32_bf16(gf, wf[J][ib], a[ib][dt], 0, 0, 0);
                    }
                }
#pragma unroll
            for (int ib = 0; ib < 2; ++ib)
#pragma unroll
                for (int dt = 0; dt < 2; ++dt) {
                    f32x4 v = a[ib][dt] + bias[ib];
                    v[0] *= bf_lo(uv[ib][dt].x); v[1] *= bf_hi(uv[ib][dt].x); v[2] *= bf_lo(uv[ib][dt].y); v[3] *= bf_hi(uv[ib][dt].y);
                    sg[ps][ib][dt] = v;
                }
            if (ps < 3) SG_STOREG((ps + 1) & 1);
            __syncthreads();
        }
#undef SG_LOADG
#undef SG_STOREG
#pragma unroll
        for (int ib = 0; ib < 2; ++ib) {
            float ss = 0.f;
#pragma unroll
            for (int ps = 0; ps < 4; ++ps)
#pragma unroll
                for (int dt = 0; dt < 2; ++dt) { const f32x4 v = sg[ps][ib][dt]; ss += (v[0] * v[0] + v[1] * v[1]) + (v[2] * v[2] + v[3] * v[3]); }
            ss = fq_sum(ss);
            if (fq == 0) red[(16 * ib + fr) * 8 + wave] = ss;
        }
        __syncthreads();
#pragma unroll
        for (int ib = 0; ib < 2; ++ib) {
            const LAS f32x4* rr = (const LAS f32x4*)(red + (16 * ib + fr) * 8); const f32x4 t = rr[0] + rr[1];
            const float rs = rsqrtf(((t[0] + t[1]) + (t[2] + t[3])) * (1.0f / 1024.0f) + EPS);
#pragma unroll
            for (int ps = 0; ps < 4; ++ps)
#pragma unroll
                for (int dt = 0; dt < 2; ++dt) {
                    const f32x4 v = sg[ps][ib][dt] * rs; u32x2 w; w.x = pk2(v[0], v[1]); w.y = pk2(v[2], v[3]);
                    *(u32x2*)(MIX + (size_t)(row0 + 16 * ib + fr) * DM + AW + (2 * ps + (wave >> 2)) * 128 + 32 * (wave & 3) + 16 * dt + 4 * fq) = w;
                }
        }
        __syncthreads();
    }
}

__device__ __forceinline__ void p2_sample_unit(const Params& p, LAS unsigned char* lds, int b) {
    const int tid = opaque(threadIdx.x), lane = tid & 63, wave = __builtin_amdgcn_readfirstlane(tid >> 6);
    unsigned char* ws = p.ws;
    const bf16_t* Q = (const bf16_t*)(ws + OFF_Q); const bf16_t* Kb = (const bf16_t*)(ws + OFF_KB); const bf16_t* Vb = (const bf16_t*)(ws + OFF_VB);
    const bf16_t* U = (const bf16_t*)(ws + OFF_U); const bf16_t* Gm = (const bf16_t*)(ws + OFF_G); bf16_t* MIX = (bf16_t*)(ws + OFF_MIX);
    const float* gss = (const float*)(ws + OFF_GSS);
    const int row0 = MP + 8 * b, fr = lane & 15, fq = lane >> 4;
    LAS float* red = (LAS float*)(lds + L_RED);
    LAS float* rgl = (LAS float*)(lds + L_RG);
    {
        f32x4 o[2][1][4];
#pragma unroll
        for (int ps = 0; ps < 2; ++ps) {
            bf16x8 qf1[1][2];
            load_q<1>(qf1, Q + (size_t)row0 * AW + (8 * ps + wave) * 64, 8, lane);
            const float sinkv = p.sinks[8 * ps + wave];
            {
                const int kr = tid >> 4, ch = tid & 15;
                f32x4 ck[4][2], cv[4][2]; u32x4 nk = (u32x4){0u, 0u, 0u, 0u}, nv = nk;
#pragma unroll
                for (int it = 0; it < 4; ++it) {
                    const size_t g = ((size_t)(b * 128 + kr + 32 * it)) * KVW + 128 * ps + ch * 8;
                    ck[it][0] = *(const f32x4*)(p.cache_k + g); ck[it][1] = *(const f32x4*)(p.cache_k + g + 4); cv[it][0] = *(const f32x4*)(p.cache_v + g); cv[it][1] = *(const f32x4*)(p.cache_v + g + 4);
                }
                if (kr < 8) { const size_t g = (size_t)(row0 + kr) * KVW + 128 * ps + ch * 8; nk = *(const u32x4*)(Kb + g); nv = *(const u32x4*)(Vb + g); }
#pragma unroll
                for (int it = 0; it < 4; ++it) {
                    const int kj = kr + 32 * it;
                    const f32x4 k0 = ck[it][0], k1 = ck[it][1], v0 = cv[it][0], v1 = cv[it][1];
                    u32x4 kv, vv;
                    kv.x = pk2(k0[0], k0[1]); kv.y = pk2(k0[2], k0[3]); kv.z = pk2(k1[0], k1[1]); kv.w = pk2(k1[2], k1[3]);
                    vv.x = pk2(v0[0], v0[1]); vv.y = pk2(v0[2], v0[3]); vv.z = pk2(v1[0], v1[1]); vv.w = pk2(v1[2], v1[3]);
                    if (kj >= 8) {
                        const size_t d = ((size_t)(b * 128 + kj - 8)) * KVW + 128 * ps + ch * 8;
                        float* kd = p.out + OUT_KWS + d; float* vd = p.out + OUT_VWS + d;
                        *(f32x4*)kd = k0; *(f32x4*)(kd + 4) = k1; *(f32x4*)vd = v0; *(f32x4*)(vd + 4) = v1;
                    }
                    const int off = ((ch >> 3) * 160 + kj) * KROW + (ch & 7) * 16;
                    *(LAS u32x4*)(lds + L_K + off) = kv; *(LAS u32x4*)(lds + L_V + off) = vv;
                }
                const int off4 = ((ch >> 3) * 160 + 128 + kr) * KROW + (ch & 7) * 16;
                *(LAS u32x4*)(lds + L_K + off4) = nk; *(LAS u32x4*)(lds + L_V + off4) = nv;
            }
            __syncthreads();
            const int head = 8 * ps + wave, kvl = wave >> 2;
            attn_core<1>(lds + L_K + kvl * KVH_BYTES, lds + L_V + kvl * KVH_BYTES, qf1, sinkv, 0, o[ps], lane);
            __syncthreads();
        }
        float ss = 0.f;
#pragma unroll
        for (int ps = 0; ps < 2; ++ps)
#pragma unroll
            for (int dt = 0; dt < 4; ++dt) { const f32x4 v = o[ps][0][dt]; ss += (v[0] * v[0] + v[1] * v[1]) + (v[2] * v[2] + v[3] * v[3]); }
        ss = fq_sum(ss);
        if (fq == 0) red[fr * 8 + wave] = ss;
        __syncthreads();
        {
            const LAS f32x4* rr = (const LAS f32x4*)(red + fr * 8); const f32x4 t = rr[0] + rr[1];
            const float ra = rsqrtf(((t[0] + t[1]) + (t[2] + t[3])) * (1.0f / 1024.0f) + EPS);
            if (fr < 8) {
#pragma unroll
                for (int ps = 0; ps < 2; ++ps)
#pragma unroll
                    for (int dt = 0; dt < 4; ++dt) {
                        const f32x4 v = o[ps][0][dt] * ra; u32x2 w; w.x = pk2(v[0], v[1]); w.y = pk2(v[2], v[3]);
                        *(u32x2*)(MIX + (size_t)(row0 + fr) * DM + (8 * ps + wave) * 64 + 16 * dt + 4 * fq) = w;
                    }
            }
        }
        __syncthreads();
    }
}
__device__ __forceinline__ void p2_sample_sg(const Params& p, LAS unsigned char* lds, int b) {
    const int tid = opaque(threadIdx.x), lane = tid & 63, wave = __builtin_amdgcn_readfirstlane(tid >> 6);
    unsigned char* ws = p.ws;
    const bf16_t* U = (const bf16_t*)(ws + OFF_U); const bf16_t* Gm = (const bf16_t*)(ws + OFF_G); bf16_t* MIX = (bf16_t*)(ws + OFF_MIX);
    const float* gss = (const float*)(ws + OFF_GSS);
    const int row0 = MP + 8 * b;
    LAS float* red = (LAS float*)(lds + L_RED);
    LAS float* rgl = (LAS float*)(lds + L_RG);
    {
        if (tid < 8) rgl[tid] = rowscale16(gss + (size_t)(row0 + tid) * 16);
        __syncthreads();
        const int col = 2 * tid, h = col >> 7;
        const float n0 = p.sg_norm[col], n1 = p.sg_norm[col + 1];
        float g0[8], g1[8];
#pragma unroll
        for (int j = 0; j < 8; ++j) {
            const unsigned gv = *(const unsigned*)(Gm + (size_t)(row0 + j) * SGW + col); const float r = rgl[j];
            g0[j] = bf_lo(gv) * r * n0; g1[j] = bf_hi(gv) * r * n1;
            float* sv = p.out + OUT_SGV + (size_t)(b * 8 + j) * SGW + col; sv[0] = g0[j]; sv[1] = g1[j];
        }
        float o0[8], o1[8];
#pragma unroll
        for (int i = 0; i < 8; ++i) {
            float m0 = p.sg_b[h * 128 + i], m1 = m0;
#pragma unroll
            for (int j = 0; j <= i; ++j) { const float w = p.sg_w[(size_t)(h * 128 + i) * 128 + j]; m0 += w * g0[j]; m1 += w * g1[j]; }
            const unsigned uv = *(const unsigned*)(U + (size_t)(row0 + i) * SGW + col);
            o0[i] = m0 * bf_lo(uv); o1[i] = m1 * bf_hi(uv);
            const float ss = wave_sum(o0[i] * o0[i] + o1[i] * o1[i]);
            if (lane == 0) red[i * 8 + wave] = ss;
        }
        __syncthreads();
#pragma unroll
        for (int i = 0; i < 8; ++i) {
            const LAS f32x4* rr = (const LAS f32x4*)(red + i * 8); const f32x4 t = rr[0] + rr[1];
            const float rs = rsqrtf(((t[0] + t[1]) + (t[2] + t[3])) * (1.0f / 1024.0f) + EPS);
            *(unsigned*)(MIX + (size_t)(row0 + i) * DM + AW + col) = pk2(o0[i] * rs, o1[i] * rs);
        }
        __syncthreads();
    }
}


typedef unsigned gu32;
#define XB_TMO      128
#define XB_XCNT(j)  (256  + 64 * (j))
#define XB_XSUB(j)  (1280 + 64 * (j))
#define XB_XGEN(j)  (2304 + 64 * (j))
#define XB_TOP      3328
#define XB_TOPGEN   3392
#define XCD_BAR_WORDS 3456
#define XB_SPIN_CAP (1u << 18)
__device__ __forceinline__ unsigned xb_ld(unsigned* p)              { return __hip_atomic_load(p, __ATOMIC_RELAXED, __HIP_MEMORY_SCOPE_AGENT); }
__device__ __forceinline__ unsigned xb_add(unsigned* p, unsigned v) { return __hip_atomic_fetch_add(p, v, __ATOMIC_RELAXED, __HIP_MEMORY_SCOPE_AGENT); }
__device__ __forceinline__ unsigned xb_xcc_id() { return (unsigned)__builtin_amdgcn_s_getreg((3 << 11) | 20) & 0xFu; }
#define XB_SPIN(cond, bar) do { unsigned _sp = 0; while (cond) { __builtin_amdgcn_s_sleep(1); \
    if ((++_sp & 255u) == 0u) { if (xb_ld(&(bar)[XB_TMO])) break; if (_sp > XB_SPIN_CAP) { atomicAdd(&(bar)[XB_TMO], 1u); break; } } } } while (0)
struct XcdBarrier { unsigned* bar; unsigned x; volatile LAS unsigned* st; };
__device__ __forceinline__ XcdBarrier xcd_barrier_post(unsigned* bar, volatile LAS unsigned* st) {
    XcdBarrier b; b.bar = bar; b.x = xb_xcc_id(); b.st = st;
    if (threadIdx.x == 0) (void)xb_add(&bar[XB_XCNT(b.x)], 1u);
    return b;
}
__device__ __forceinline__ void xcd_barrier_complete(unsigned* bar, unsigned x, unsigned& nloc, unsigned& nx) {
    const unsigned G = gridDim.x * gridDim.y * gridDim.z;
    unsigned sum, cnt, mine, sp = 0u;
    for (;;) {
        sum = 0u; cnt = 0u; mine = 0u;
#pragma unroll
        for (unsigned j = 0; j < 16; ++j) { const unsigned c = xb_ld(&bar[XB_XCNT(j)]); sum += c; cnt += (c > 0u) ? 1u : 0u; mine = (j == x) ? c : mine; }
        if (sum == G) break;
        __builtin_amdgcn_s_sleep(1);
        if ((++sp & 255u) == 0u) { if (xb_ld(&bar[XB_TMO])) break; if (sp > XB_SPIN_CAP) { atomicAdd(&bar[XB_TMO], 1u); break; } }
    }
    nloc = mine > 0u ? mine : 1u; nx = cnt > 0u ? cnt : 1u;
}
__device__ __forceinline__ void xcd_barrier(const XcdBarrier& b) {
    asm volatile("s_waitcnt vmcnt(0)" ::: "memory");
    __syncthreads();
    if (threadIdx.x == 0) {
        unsigned* bar = b.bar;
        __builtin_amdgcn_s_waitcnt(0);
        unsigned nloc = b.st[0], nx = b.st[1];
        if (nloc == 0u) { xcd_barrier_complete(bar, b.x, nloc, nx); b.st[0] = nloc; b.st[1] = nx; }
        const unsigned old = xb_add(&bar[XB_XSUB(b.x)], 1u);
        const unsigned gen = old / nloc;
        if (old + 1u == (gen + 1u) * nloc) {
            __builtin_amdgcn_fence(__ATOMIC_RELEASE, "agent");
            asm volatile("s_waitcnt vmcnt(0)" ::: "memory");
            const unsigned og = xb_add(&bar[XB_TOP], 1u);
            const unsigned tg = og / nx;
            if (og + 1u == (tg + 1u) * nx) xb_add(&bar[XB_TOPGEN], 1u);
            else XB_SPIN(xb_ld(&bar[XB_TOPGEN]) == tg, bar);
            __builtin_amdgcn_fence(__ATOMIC_ACQUIRE, "agent");
            xb_add(&bar[XB_XGEN(b.x)], 1u);
            asm volatile("s_waitcnt vmcnt(0)" ::: "memory");
        } else {
            XB_SPIN(xb_ld(&bar[XB_XGEN(b.x)]) == gen, bar);
            __builtin_amdgcn_fence(__ATOMIC_ACQUIRE, "agent");
            asm volatile("s_waitcnt vmcnt(0)" ::: "memory");
        }
    }
    __syncthreads();
}

#ifndef P3_MAXSF
#define P3_MAXSF 4
#endif
#ifndef P4_MAXSF
#define P4_MAXSF 4
#endif
#ifndef REP_P0
#define REP_P0 0
#endif
#ifndef REP_P2
#define REP_P2 0
#endif
#ifndef REP_P1
#define REP_P1 0
#endif
#ifndef REP_P3
#define REP_P3 0
#endif
#ifndef REP_P4
#define REP_P4 0
#endif
#ifndef EXTRA_SYNCS
#define EXTRA_SYNCS 0
#endif
#ifndef USE_CG_SYNC
#define USE_CG_SYNC 0
#endif
constexpr int LDS_BYTES = 147456;
__global__ void __launch_bounds__(512, 2) hymba_fwd(Params p) {
    extern __shared__ __attribute__((aligned(16))) unsigned char lds_raw[];
    LAS unsigned char* lds = (LAS unsigned char*)lds_raw;
    cg::grid_group grid = cg::this_grid();
    const int G = gridDim.x;
    unsigned char* ws = p.ws;
    volatile LAS unsigned* bst = (volatile LAS unsigned*)(lds + 147200);
    if (threadIdx.x < 2) bst[threadIdx.x] = 0u;
    __syncthreads();
    const XcdBarrier xbar = xcd_barrier_post((unsigned*)(ws + OFF_BAR), bst);
    if (p.out == nullptr) grid.sync();
#if USE_CG_SYNC
#define SEAM() grid.sync()
#else
#define SEAM() xcd_barrier(xbar)
#endif

#pragma unroll 1
    for (int rep = 0; rep <= REP_P0; ++rep) {
    p0_prologue(p, lds);
    SEAM();
    }
#pragma unroll 1
    for (int rep = 0; rep < EXTRA_SYNCS; ++rep) SEAM();
#pragma unroll 1
    for (int rep1 = 0; rep1 <= REP_P1; ++rep1) {
        pg8::Gemm g{(const bf16_t*)(ws + OFF_XN), (const bf16_t*)(ws + OFF_WIN), MT, INW, DM}; pg8::TailSplitOrder S; S.init(MT, INW, DM, G, (int)blockIdx.x);
        EpiProj E{(bf16_t*)(ws + OFF_Q), (bf16_t*)(ws + OFF_KB), (bf16_t*)(ws + OFF_VB), (bf16_t*)(ws + OFF_U), (bf16_t*)(ws + OFF_G), (float*)(ws + OFF_GSS),
                  (const float*)(ws + OFF_ROPE), p.q_norm, p.k_norm, p.out};
        const pg8::SplitCtx sc{(float*)(ws + OFF_WO), 1 << 30, nullptr, (unsigned*)(ws + OFF_BAR + 16384)};
        pg8::gemm_phase(lds, g, S, E, sc);
    SEAM();
    }
#pragma unroll 1
    for (int rep = 0; rep <= REP_P2; ++rep) {
        for (int u = blockIdx.x; u < 256; u += G) { p2_prompt_att(p, lds, u); p2_prompt_sg(p, lds, u); }
        for (int i = blockIdx.x; i < 256; i += G) { if (i < 128) p2_sample_unit(p, lds, i); else p2_sample_sg(p, lds, i - 128); }
        SEAM();
    }
#pragma unroll 1
    for (int rep3 = 0; rep3 <= REP_P3; ++rep3) {
        pg8::Gemm g{(const bf16_t*)(ws + OFF_MIX), (const bf16_t*)(ws + OFF_WO), MT, DM, DM}; pg8::TailSplitOrder S; S.init(MT, DM, DM, G, (int)blockIdx.x, P3_MAXSF);
        EpiWo E{p, (bf16_t*)(ws + OFF_HB), (float*)(ws + OFF_HSS), (const bf16_t*)(ws + OFF_XN), (const float*)(ws + OFF_RX)};
        const pg8::SplitCtx sc{(float*)(ws + OFF_Q), 1 << 30, nullptr, (unsigned*)(ws + OFF_BAR + 16384) + 1024};
        pg8::gemm_phase(lds, g, S, E, sc);
    SEAM();
    }
#pragma unroll 1
    for (int rep4 = 0; rep4 <= REP_P4; ++rep4) {
        pg8::Gemm g{(const bf16_t*)(ws + OFF_HB), (const bf16_t*)(ws + OFF_WGU), MT, 2 * FF, DM}; pg8::TailSplitOrder S; S.init(MT, 2 * FF, DM, G, (int)blockIdx.x, P4_MAXSF);
        EpiGU E{(const float*)(ws + OFF_HSS), (bf16_t*)(ws + OFF_ACT)};
        const pg8::SplitCtx sc{(float*)(ws + OFF_WIN), (int)((OFF_WGU - OFF_WIN) / 262144), (float*)(ws + OFF_MIX), (unsigned*)(ws + OFF_BAR + 16384) + 2048};
        pg8::gemm_phase(lds, g, S, E, sc);
    SEAM();
    }
    {
        pg8::Gemm g{(const bf16_t*)(ws + OFF_ACT), (const bf16_t*)(ws + OFF_WDN), MT, DM, FF}; pg8::TailSplitOrder S; S.init(MT, DM, FF, G, (int)blockIdx.x);
        EpiDown E{p.out, (const bf16_t*)(ws + OFF_HB)};
        const pg8::SplitCtx sc{(float*)(ws + OFF_WIN), 1 << 30, nullptr, (unsigned*)(ws + OFF_BAR + 16384) + 3072};
        pg8::gemm_phase(lds, g, S, E, sc);
    }
}

extern "C" void kernel_launch(void* const* d_in, const int* in_sizes, int n_in, void* d_out, int out_size, void* d_ws, size_t ws_size, hipStream_t stream) {
    static int grid = 0;
    if (grid == 0) {
        if (n_in != 19 || ws_size < WS_END) { fprintf(stderr, "kernel_launch: need 19 inputs and >= %zu bytes of workspace (got %d, %zu)\n", (size_t)WS_END, n_in, ws_size); grid = -1; return; }
        int dev = 0, cus = 0, per_cu = 0;
        hipGetDevice(&dev);
        hipDeviceGetAttribute(&cus, hipDeviceAttributeMultiprocessorCount, dev);
        if (hipFuncSetAttribute((const void*)hymba_fwd, hipFuncAttributeMaxDynamicSharedMemorySize, LDS_BYTES) != hipSuccess) { fprintf(stderr, "kernel_launch: hipFuncSetAttribute failed\n"); grid = -1; return; }
        if (hipOccupancyMaxActiveBlocksPerMultiprocessor(&per_cu, (const void*)hymba_fwd, 512, LDS_BYTES) != hipSuccess || per_cu < 1) { fprintf(stderr, "kernel_launch: occupancy query failed (%d)\n", per_cu); per_cu = 1; }
        (void)hipGetLastError();
        grid = cus * (per_cu > 1 ? 1 : per_cu);
    }
    if (grid < 0) return;
    if (hipMemsetAsync((char*)d_ws + OFF_BAR, 0, BAR_BYTES, stream) != hipSuccess) { fprintf(stderr, "kernel_launch: memset failed\n"); return; }
    Params p{};
    const float** f = (const float**)&p;
    for (int i = 0; i < 19; ++i) f[i] = (const float*)d_in[i];
    p.out = (float*)d_out; p.ws = (unsigned char*)d_ws;
    void* args[] = {&p};
    hipError_t e = hipLaunchCooperativeKernel((const void*)hymba_fwd, dim3(grid), dim3(512), args, LDS_BYTES, stream);
    if (e != hipSuccess) fprintf(stderr, "cooperative launch failed: %s (grid %d)\n", hipGetErrorString(e), grid);
}
```
